# Optimizing an MI355X kernel written in HIP

```python
import jax, jax.numpy as jnp
from jax import lax
import numpy as np

D_MODEL = 1024
BATCH = 8
SEQ = 4096
DEPTH = 1

LRU_WIDTH = D_MODEL
LRU_BLOCKS = 16
LRU_BLOCK = LRU_WIDTH // LRU_BLOCKS
CONV_WIDTH = 4
LRU_C = 8.0
ATT_HEADS = 8
ATT_HEAD_DIM = D_MODEL // ATT_HEADS
ATT_KV_HEADS = 2
ATT_GROUP = ATT_HEADS // ATT_KV_HEADS
IDX_HEADS = 8
IDX_DIM = 64
TOPK_MAX = 256
Q_BLOCK = 128
MEM_HEADS = 4
MEM_HEAD_DIM = D_MODEL // MEM_HEADS
N_BRANCH = 3
PEER_HEADS = 8
PEER_KEYS = 128
PEER_EXPERTS = PEER_KEYS * PEER_KEYS
PEER_QDIM = 256
PEER_SUBDIM = PEER_QDIM // 2
PEER_TOPK = 16
PEER_CHUNK = 128
ROPE_THETA = 10000.0
EPS = 1e-6

SPLIT_SIZES = (LRU_WIDTH, LRU_WIDTH,
               ATT_HEADS * ATT_HEAD_DIM, ATT_KV_HEADS * ATT_HEAD_DIM, ATT_KV_HEADS * ATT_HEAD_DIM,
               IDX_HEADS * IDX_DIM, IDX_DIM, IDX_HEADS,
               MEM_HEADS * MEM_HEAD_DIM,
               N_BRANCH * D_MODEL)
IN_WIDTH = sum(SPLIT_SIZES)
SPLIT_POINTS = tuple(sum(SPLIT_SIZES[:i + 1]) for i in range(len(SPLIT_SIZES) - 1))

kernel_name = "hybrid_rglru_dsa_mem_peer_block"


def rmsnorm(x, g):
    xf = x.astype(jnp.float32)
    y = xf * lax.rsqrt(jnp.mean(xf * xf, axis=-1, keepdims=True) + EPS)
    return (y * g.astype(jnp.float32)).astype(x.dtype)


def rope(x, pos):
    half = x.shape[-1] // 2
    freq = ROPE_THETA ** (-jnp.arange(half, dtype=jnp.float32) / half)
    ang = pos.astype(jnp.float32)[:, None] * freq[None, :]
    cos = jnp.cos(ang)[None, :, None, :]
    sin = jnp.sin(ang)[None, :, None, :]
    xf = x.astype(jnp.float32)
    x1, x2 = xf[..., :half], xf[..., half:]
    return jnp.concatenate([x1 * cos - x2 * sin, x2 * cos + x1 * sin], axis=-1).astype(x.dtype)


def causal_depthwise_conv(x, w, b):
    y = lax.conv_general_dilated(x, w[:, None, :].astype(x.dtype), window_strides=(1,),
                                 padding=[(CONV_WIDTH - 1, 0)],
                                 dimension_numbers=('NWC', 'WIO', 'NWC'),
                                 feature_group_count=x.shape[-1])
    return y + b.astype(x.dtype)


def rg_lru(x, w_a, b_a, w_i, b_i, lam):
    B, S, C = x.shape
    xb = x.reshape(B, S, LRU_BLOCKS, LRU_BLOCK)
    r = jax.nn.sigmoid(jnp.einsum('bsnc,ncd->bsnd', xb, w_a) + b_a).reshape(B, S, C)
    i = jax.nn.sigmoid(jnp.einsum('bsnc,ncd->bsnd', xb, w_i) + b_i).reshape(B, S, C)
    log_a = -LRU_C * r.astype(jnp.float32) * jax.nn.softplus(-lam.astype(jnp.float32))
    a = jnp.exp(log_a)
    mult = jnp.sqrt(-jnp.expm1(2.0 * log_a))
    u = mult * (i * x).astype(jnp.float32)

    def combine(left, right):
        a1, b1 = left
        a2, b2 = right
        return a1 * a2, a2 * b1 + b2

    _, h = lax.associative_scan(combine, (a, u), axis=1)
    return h.astype(x.dtype)


def dsa_attention(q, k, v, qi, ki, wi):
    B, S = q.shape[0], q.shape[1]
    topk = min(TOPK_MAX, S // 4)
    nb = S // Q_BLOCK
    kpos = jnp.arange(S)
    qpos = kpos.reshape(nb, Q_BLOCK)
    ki_f = ki.astype(jnp.float32)

    def to_blocks(t):
        return jnp.moveaxis(t.reshape((B, nb, Q_BLOCK) + t.shape[2:]), 1, 0)

    def block(args):
        qb, qib, wib, pos = args
        logits = jnp.einsum('bqhd,bsd->bqhs', qib.astype(jnp.float32), ki_f)
        score = jnp.einsum('bqhs,bqh->bqs', jax.nn.relu(logits), wib.astype(jnp.float32))
        causal = kpos[None, :] <= pos[:, None]
        score = jnp.where(causal[None], score, -jnp.inf)
        _, idx = lax.top_k(score, topk)
        valid = idx <= pos[None, :, None]
        kg = jax.vmap(lambda kb, ib: kb[ib])(k, idx)
        vg = jax.vmap(lambda vb, ib: vb[ib])(v, idx)
        qg = qb.reshape(B, Q_BLOCK, ATT_KV_HEADS, ATT_GROUP, ATT_HEAD_DIM)
        s = jnp.einsum('bqgrd,bqkgd->bqgrk', qg, kg).astype(jnp.float32) * (ATT_HEAD_DIM ** -0.5)
        s = jnp.where(valid[:, :, None, None, :], s, -jnp.inf)
        p = jax.nn.softmax(s, axis=-1).astype(vg.dtype)
        o = jnp.einsum('bqgrk,bqkgd->bqgrd', p, vg)
        return o.reshape(B, Q_BLOCK, ATT_HEADS * ATT_HEAD_DIM)

    out = lax.map(block, (to_blocks(q), to_blocks(qi), to_blocks(wi), qpos))
    return jnp.moveaxis(out, 0, 1).reshape(B, S, ATT_HEADS * ATT_HEAD_DIM)


def memory_attention(q, mk, mv):
    B, S = q.shape[0], q.shape[1]
    s = jnp.einsum('bshd,bmhd->bhsm', q, mk).astype(jnp.float32) * (MEM_HEAD_DIM ** -0.5)
    p = jax.nn.softmax(s, axis=-1).astype(mv.dtype)
    o = jnp.einsum('bhsm,bmhd->bshd', p, mv)
    return o.reshape(B, S, MEM_HEADS * MEM_HEAD_DIM)


def peer(x, w_q, sub_keys, u, v):
    B, S, D = x.shape
    q = (x @ w_q).reshape(B, S, PEER_HEADS, 2, PEER_SUBDIM)
    sc = jnp.einsum('bshpc,hpkc->bshpk', q, sub_keys).astype(jnp.float32)
    s1, i1 = lax.top_k(sc[..., 0, :], PEER_TOPK)
    s2, i2 = lax.top_k(sc[..., 1, :], PEER_TOPK)
    cand = (s1[..., :, None] + s2[..., None, :]).reshape(B, S, PEER_HEADS, PEER_TOPK * PEER_TOPK)
    cand_idx = (i1[..., :, None] * PEER_KEYS + i2[..., None, :]).reshape(B, S, PEER_HEADS, PEER_TOPK * PEER_TOPK)
    top_s, sel = lax.top_k(cand, PEER_TOPK)
    eidx = jnp.take_along_axis(cand_idx, sel, axis=-1)
    g = jax.nn.softmax(top_s, axis=-1)
    T = B * S
    nc = T // PEER_CHUNK
    xs = x.reshape(nc, PEER_CHUNK, D)
    es = eidx.reshape(nc, PEER_CHUNK, PEER_HEADS, PEER_TOPK)
    gs = g.reshape(nc, PEER_CHUNK, PEER_HEADS, PEER_TOPK)

    def chunk(args):
        xc, ic, gc = args
        uc = u[ic]
        act = jax.nn.gelu(jnp.einsum('chkd,cd->chk', uc, xc).astype(jnp.float32)) * gc
        vc = v[ic]
        return jnp.einsum('chk,chkd->cd', act.astype(vc.dtype), vc)

    out = lax.map(chunk, (xs, es, gs))
    return out.reshape(B, S, D)


def setup_inputs(seed: int = 0) -> dict:
    key = jax.random.key(seed)
    ks = jax.random.split(key, 26)
    f32 = jnp.float32
    nrm = lambda k, shape, s: jax.random.normal(k, shape, f32) * s
    gain = lambda k, shape: 1.0 + 0.02 * jax.random.normal(k, shape, f32)
    a_c = jax.random.uniform(ks[9], (DEPTH, LRU_WIDTH), f32, minval=0.9, maxval=0.999)
    p = a_c ** (1.0 / LRU_C)
    lam = jnp.log(p) - jnp.log1p(-p)
    return {
        "x": nrm(ks[0], (BATCH, SEQ, D_MODEL), 1.0),
        "mem": nrm(ks[1], (BATCH, 256, D_MODEL), 1.0),
        "norm_mix": gain(ks[2], (DEPTH, D_MODEL)),
        "w_in": nrm(ks[3], (DEPTH, D_MODEL, IN_WIDTH), D_MODEL ** -0.5),
        "conv_w": nrm(ks[4], (DEPTH, CONV_WIDTH, LRU_WIDTH), CONV_WIDTH ** -0.5),
        "conv_b": nrm(ks[5], (DEPTH, LRU_WIDTH), 0.01),
        "lru_wa": nrm(ks[6], (DEPTH, LRU_BLOCKS, LRU_BLOCK, LRU_BLOCK), LRU_BLOCK ** -0.5),
        "lru_ba": nrm(ks[7], (DEPTH, LRU_BLOCKS, LRU_BLOCK), 0.01),
        "lru_wi": nrm(ks[8], (DEPTH, LRU_BLOCKS, LRU_BLOCK, LRU_BLOCK), LRU_BLOCK ** -0.5),
        "lru_bi": nrm(ks[10], (DEPTH, LRU_BLOCKS, LRU_BLOCK), 0.01),
        "lru_lambda": lam,
        "q_norm": gain(ks[11], (DEPTH, ATT_HEAD_DIM)),
        "k_norm": gain(ks[12], (DEPTH, ATT_HEAD_DIM)),
        "idx_k_norm": gain(ks[13], (DEPTH, IDX_DIM)),
        "mem_norm": gain(ks[14], (DEPTH, D_MODEL)),
        "w_mem_kv": nrm(ks[15], (DEPTH, D_MODEL, 2 * MEM_HEADS * MEM_HEAD_DIM), D_MODEL ** -0.5),
        "mem_q_norm": gain(ks[16], (DEPTH, MEM_HEAD_DIM)),
        "mem_k_norm": gain(ks[17], (DEPTH, MEM_HEAD_DIM)),
        "w_out": nrm(ks[18], (DEPTH, D_MODEL, D_MODEL), D_MODEL ** -0.5),
        "norm_ffn": gain(ks[19], (DEPTH, D_MODEL)),
        "peer_wq": nrm(ks[20], (DEPTH, D_MODEL, PEER_HEADS * PEER_QDIM), D_MODEL ** -0.5),
        "peer_subkeys": nrm(ks[21], (DEPTH, PEER_HEADS, 2, PEER_KEYS, PEER_SUBDIM), PEER_SUBDIM ** -0.5),
        "peer_u": nrm(ks[22], (DEPTH, PEER_EXPERTS, D_MODEL), D_MODEL ** -0.5),
        "peer_v": nrm(ks[23], (DEPTH, PEER_EXPERTS, D_MODEL), PEER_HEADS ** -0.5),
    }


def reference(x, mem, norm_mix, w_in, conv_w, conv_b, lru_wa, lru_ba, lru_wi, lru_bi, lru_lambda,
              q_norm, k_norm, idx_k_norm, mem_norm, w_mem_kv, mem_q_norm, mem_k_norm, w_out,
              norm_ffn, peer_wq, peer_subkeys, peer_u, peer_v):
    B, S, D = x.shape
    M = mem.shape[1]
    pos = jnp.arange(S)
    for l in range(DEPTH):
        h = rmsnorm(x, norm_mix[l])
        (lru_x, lru_gate, q, k, v, qi, ki, wi, mq, gates) = jnp.split(h @ w_in[l], SPLIT_POINTS, axis=-1)

        xc = causal_depthwise_conv(lru_x, conv_w[l], conv_b[l])
        y_lru = rg_lru(xc, lru_wa[l], lru_ba[l], lru_wi[l], lru_bi[l], lru_lambda[l]) * jax.nn.gelu(lru_gate)

        q = rope(rmsnorm(q.reshape(B, S, ATT_HEADS, ATT_HEAD_DIM), q_norm[l]), pos)
        k = rope(rmsnorm(k.reshape(B, S, ATT_KV_HEADS, ATT_HEAD_DIM), k_norm[l]), pos)
        v = v.reshape(B, S, ATT_KV_HEADS, ATT_HEAD_DIM)
        qi = rope(qi.reshape(B, S, IDX_HEADS, IDX_DIM), pos) * (IDX_DIM ** -0.5)
        ki = rope(rmsnorm(ki, idx_k_norm[l])[:, :, None, :], pos)[:, :, 0, :]
        wi = wi * (IDX_HEADS ** -0.5)
        y_att = dsa_attention(q, k, v, qi, ki, wi)

        m = rmsnorm(mem, mem_norm[l])
        mk, mv = jnp.split(m @ w_mem_kv[l], 2, axis=-1)
        mk = rmsnorm(mk.reshape(B, M, MEM_HEADS, MEM_HEAD_DIM), mem_k_norm[l])
        mv = mv.reshape(B, M, MEM_HEADS, MEM_HEAD_DIM)
        mq = rmsnorm(mq.reshape(B, S, MEM_HEADS, MEM_HEAD_DIM), mem_q_norm[l])
        y_mem = memory_attention(mq, mk, mv)

        g = jax.nn.sigmoid(gates.reshape(B, S, N_BRANCH, D))
        merged = g[:, :, 0, :] * y_lru + g[:, :, 1, :] * y_att + g[:, :, 2, :] * y_mem
        x = x + merged @ w_out[l]

        x = x + peer(rmsnorm(x, norm_ffn[l]), peer_wq[l], peer_subkeys[l], peer_u[l], peer_v[l])
    return x
```

```cpp
#include <hip/hip_runtime.h>
#include <hip/hip_cooperative_groups.h>
#include <cstdio>
namespace cg = cooperative_groups;

#define LAS __attribute__((address_space(3)))
#define LDS_WAIT() asm volatile("s_waitcnt lgkmcnt(0)" ::: "memory")
typedef unsigned short bf16_t;
typedef short bf16x8 __attribute__((ext_vector_type(8)));
typedef float f32x4 __attribute__((ext_vector_type(4)));
typedef float f32x2 __attribute__((ext_vector_type(2)));
typedef unsigned u32x4 __attribute__((ext_vector_type(4)));
typedef unsigned u32x2 __attribute__((ext_vector_type(2)));

constexpr int T_TOK = 32768, DM = 1024, SEQ = 4096, NBATCH = 8, MEMT = 256;
constexpr int N1 = 5376;
constexpr int NGATE = 4096;
constexpr int NWAVES = 8, NTHREADS = 512;
constexpr float EPS = 1e-6f;

constexpr size_t MiB = 1ull << 20;
constexpr size_t WS_CTL = 0;
constexpr size_t WS_CONST = 65536;
constexpr int C_CONVW = 0, C_CONVB = 4096, C_LBA = 5120, C_LBI = 6144, C_LAM = 7168, C_QN = 8192, C_KN = 8320, C_IKN = 8448, C_MQN = 8512, C_MKN = 8768, C_NFFN = 9024, C_END = 10048;
constexpr size_t WS_ROPE64 = 1 * MiB;
constexpr size_t WS_ROPE32 = 3 * MiB;
constexpr size_t WS_LRUS = 4 * MiB;
constexpr size_t WS_WAT = 6 * MiB;
constexpr size_t WS_WIT = 6 * MiB + 256 * 1024;
constexpr size_t WS_SUBK = 7 * MiB;
constexpr size_t WS_MN = 8 * MiB;
constexpr size_t WS_MKV = 12 * MiB;
constexpr size_t WS_MKN = 20 * MiB;
constexpr size_t WS_MVT = 24 * MiB;
constexpr size_t WS_W1T = 28 * MiB;
constexpr size_t WS_W1TB = 34 * MiB;
constexpr int N1F = 4608, N1B = 768;
constexpr size_t WS_WGT = 40 * MiB;
constexpr size_t WS_WOT = 48 * MiB;
constexpr size_t WS_WKVT = 50 * MiB;
constexpr size_t WS_WQT = 54 * MiB;
constexpr size_t WS_KN = 60 * MiB;
constexpr size_t WS_KIN = 76 * MiB;
constexpr size_t WS_IDX = 80 * MiB;
constexpr size_t WS_XN = 96 * MiB;
constexpr size_t WS_LX = 160 * MiB;
constexpr size_t WS_GG = 224 * MiB;
constexpr size_t WS_Q = 288 * MiB;
constexpr size_t WS_MQ = 352 * MiB;
constexpr size_t WS_KR = 416 * MiB;
constexpr size_t WS_V = 432 * MiB;
constexpr size_t WS_QI = 448 * MiB;
constexpr size_t WS_KW = 480 * MiB;
constexpr size_t WS_K8 = 496 * MiB;
constexpr size_t WS_END = 504 * MiB;
constexpr float K8_SCALE = 8.0f;
constexpr float X8_SCALE = 8.0f, W8_SCALE = 64.0f;
constexpr int   XW_E8M0 = 127 - 3 - 6;
constexpr size_t WS_MG = WS_LX;
constexpr size_t WS_PQ = WS_LX;
constexpr size_t WS_UB = WS_Q;
constexpr size_t WS_VB = WS_Q + 32 * MiB;
constexpr size_t WS_EIDX = WS_MQ;
constexpr size_t WS_EG = WS_MQ + 16 * MiB;

constexpr int LDS_BYTES = 156672;
constexpr int LDS_XB_OFF = LDS_BYTES, LDS_TOTAL = LDS_BYTES + 16;

struct Params {
    const float* x; const float* mem; const float* norm_mix; const float* w_in; const float* conv_w; const float* conv_b;
    const float* lru_wa; const float* lru_ba; const float* lru_wi; const float* lru_bi; const float* lru_lambda;
    const float* q_norm; const float* k_norm; const float* idx_k_norm; const float* mem_norm; const float* w_mem_kv;
    const float* mem_q_norm; const float* mem_k_norm; const float* w_out; const float* norm_ffn; const float* peer_wq;
    const float* peer_subkeys; const float* peer_u; const float* peer_v;
    float* out; unsigned char* ws;
};

typedef float f32x2_t_ __attribute__((ext_vector_type(2)));
typedef __bf16 bf16x2_t_ __attribute__((ext_vector_type(2)));
__device__ __forceinline__ unsigned pk2(float lo, float hi) { const f32x2_t_ v = {lo, hi}; const bf16x2_t_ b = __builtin_convertvector(v, bf16x2_t_); return __builtin_bit_cast(unsigned, b); }
__device__ __forceinline__ unsigned f2bf(float f) { return (unsigned)__builtin_bit_cast(unsigned short, (__bf16)f); }
__device__ __forceinline__ float bf2f(unsigned short b) { return __uint_as_float(((unsigned)b) << 16); }
__device__ __forceinline__ float bflo(unsigned u) { return __uint_as_float(u << 16); }
__device__ __forceinline__ float bfhi(unsigned u) { return __uint_as_float(u & 0xffff0000u); }
__device__ __forceinline__ float frcp(float x) { return __builtin_amdgcn_rcpf(x); }
__device__ __forceinline__ float sigmoidf_(float x) { return frcp(1.0f + __expf(-x)); }
__device__ __forceinline__ float gelu_tanh(float x) { const float u = 1.5957691216057308f * (x + 0.044715f * x * x * x); return x * frcp(1.0f + __expf(-u)); }
__device__ __forceinline__ float wave_sum(float v) {
#pragma unroll
    for (int o = 1; o < 64; o <<= 1) v += __shfl_xor(v, o);
    return v;
}
__device__ __forceinline__ bf16x8 pack8(const float* v) {
    u32x4 w; w.x = pk2(v[0], v[1]); w.y = pk2(v[2], v[3]); w.z = pk2(v[4], v[5]); w.w = pk2(v[6], v[7]);
    return __builtin_bit_cast(bf16x8, w);
}
__device__ __forceinline__ void unpack8(u32x4 w, float* v) {
    v[0] = bflo(w.x); v[1] = bfhi(w.x); v[2] = bflo(w.y); v[3] = bfhi(w.y); v[4] = bflo(w.z); v[5] = bfhi(w.z); v[6] = bflo(w.w); v[7] = bfhi(w.w);
}
__device__ __forceinline__ int fresh_lane() { unsigned m = 0xffffffffu; asm volatile("" : "+s"(m)); return (int)__builtin_amdgcn_mbcnt_hi(m, __builtin_amdgcn_mbcnt_lo(m, 0u)); }
#define MFMA16(a, b, c) __builtin_amdgcn_mfma_f32_16x16x32_bf16((a), (b), (c), 0, 0, 0)


#define XB_TMO      128
#define XB_XCNT(j)  (256  + 64 * (j))
#define XB_XSUB(j)  (1280 + 64 * (j))
#define XB_XGEN(j)  (2304 + 64 * (j))
#define XB_TOP      3328
#define XB_TOPGEN   3392
#define XCD_BAR_WORDS 3456
#define XB_SPIN_CAP (1u << 23)
__device__ __forceinline__ unsigned xb_ld(unsigned* p)              { return __hip_atomic_load(p, __ATOMIC_RELAXED, __HIP_MEMORY_SCOPE_AGENT); }
__device__ __forceinline__ unsigned xb_add(unsigned* p, unsigned v) { return __hip_atomic_fetch_add(p, v, __ATOMIC_RELAXED, __HIP_MEMORY_SCOPE_AGENT); }
__device__ __forceinline__ unsigned xb_xcc_id() { return (unsigned)__builtin_amdgcn_s_getreg((3 << 11) | 20) & 0xFu; }
#define XB_SPIN(cond, bar) do { unsigned _sp = 0; while (cond) { __builtin_amdgcn_s_sleep(1); \
    if ((++_sp & 255u) == 0u) { if (xb_ld(&(bar)[XB_TMO])) break; if (_sp > XB_SPIN_CAP) { atomicAdd(&(bar)[XB_TMO], 1u); break; } } } } while (0)
struct XcdBarrier { unsigned* bar; unsigned x; volatile LAS unsigned* st; };
__device__ __forceinline__ XcdBarrier xcd_barrier_post(unsigned* bar, volatile LAS unsigned* st, int wave_id) {
    XcdBarrier b; b.bar = bar; b.x = xb_xcc_id(); b.st = st;
    if (wave_id == 0 && fresh_lane() == 0) (void)xb_add(&bar[XB_XCNT(b.x)], 1u);
    return b;
}
__device__ __forceinline__ void xcd_barrier_complete(unsigned* bar, unsigned x, unsigned& nloc, unsigned& nx) {
    const unsigned G = gridDim.x * gridDim.y * gridDim.z;
    unsigned sum, cnt, mine, sp = 0u;
    for (;;) {
        sum = 0u; cnt = 0u; mine = 0u;
#pragma unroll
        for (unsigned j = 0; j < 16; ++j) { const unsigned c = xb_ld(&bar[XB_XCNT(j)]); sum += c; cnt += (c > 0u) ? 1u : 0u; mine = (j == x) ? c : mine; }
        if (sum == G) break;
        __builtin_amdgcn_s_sleep(1);
        if ((++sp & 255u) == 0u) { if (xb_ld(&bar[XB_TMO])) break; if (sp > XB_SPIN_CAP) { atomicAdd(&bar[XB_TMO], 1u); break; } }
    }
    nloc = mine > 0u ? mine : 1u; nx = cnt > 0u ? cnt : 1u;
}
__device__ __forceinline__ void xcd_barrier(const XcdBarrier& b, int wave_id) {
    asm volatile("s_waitcnt vmcnt(0)" ::: "memory");
    __syncthreads();
    if (wave_id == 0 && fresh_lane() == 0) {
        unsigned* bar = b.bar;
        __builtin_amdgcn_s_waitcnt(0);
        unsigned nloc = b.st[0], nx = b.st[1];
        if (nloc == 0u) { xcd_barrier_complete(bar, b.x, nloc, nx); b.st[0] = nloc; b.st[1] = nx; }
        const unsigned old = xb_add(&bar[XB_XSUB(b.x)], 1u);
        const unsigned gen = old / nloc;
        if (old + 1u == (gen + 1u) * nloc) {
            __builtin_amdgcn_fence(__ATOMIC_RELEASE, "agent");
            asm volatile("s_waitcnt vmcnt(0)" ::: "memory");
            const unsigned og = xb_add(&bar[XB_TOP], 1u);
            const unsigned tg = og / nx;
            if (og + 1u == (tg + 1u) * nx) xb_add(&bar[XB_TOPGEN], 1u);
            else XB_SPIN(xb_ld(&bar[XB_TOPGEN]) == tg, bar);
            __builtin_amdgcn_fence(__ATOMIC_ACQUIRE, "agent");
            xb_add(&bar[XB_XGEN(b.x)], 1u);
            asm volatile("s_waitcnt vmcnt(0)" ::: "memory");
        } else {
            XB_SPIN(xb_ld(&bar[XB_XGEN(b.x)]) == gen, bar);
            __builtin_amdgcn_fence(__ATOMIC_ACQUIRE, "agent");
            asm volatile("s_waitcnt vmcnt(0)" ::: "memory");
        }
    }
    __syncthreads();
}

namespace pg8 {
typedef int i32x4_t __attribute__((ext_vector_type(4)));
typedef int i32x8_t __attribute__((ext_vector_type(8)));
__device__ __forceinline__ i32x8_t cat8(bf16x8 a, bf16x8 b) { return __builtin_shufflevector(__builtin_bit_cast(i32x4_t, a), __builtin_bit_cast(i32x4_t, b), 0, 1, 2, 3, 4, 5, 6, 7); }
constexpr int BM = 256, BK = 64, HALF = 128, HTB = HALF * BK * 2, STAGE_BYTES = 8 * HTB, NXCD = 8, WGM = 8;
__host__ __device__ __forceinline__ int lds_byte(int r, int c) { const int st = (r >> 4) * 2 + (c >> 5), rr = r & 15, cc = c & 31, ob = rr * 64 + cc * 2; return st * 1024 + (ob ^ (((ob >> 9) & 1) << 5)); }
__host__ __device__ __forceinline__ void stage_rc(int b, int& R, int& C) { const int st = b / 1024, sb = b % 1024, swz = sb ^ (((sb >> 9) & 1) << 5); R = (st >> 1) * 16 + swz / 64; C = (st & 1) * 32 + (swz % 64) / 2; }
__host__ __device__ __forceinline__ int perm32(int rho) { const int n = rho >> 4, i = rho & 15; return 8 * (i >> 2) + 4 * n + (i & 3); }
struct Unit { int pm, pn; };
struct Gemm { const bf16_t* A; const bf16_t* Bt; int M, N, K; };
struct StaticOrder {
    int nM, nN, nwg, G, c;
    __host__ __device__ void init(int M, int N, int G_, int c_) { nM = M / BM; nN = N / BM; nwg = nM * nN; G = G_; c = c_; }
    __host__ __device__ bool next(int i, Unit& u) const {
        const long L = (long)i * G + c; if (L >= nwg) return false;
        int wgid = (int)L; { const int q = nwg / NXCD, r = nwg % NXCD, xcd = wgid % NXCD, off = wgid / NXCD; wgid = (xcd < r ? xcd * (q + 1) : r * (q + 1) + (xcd - r) * q) + off; }
        const int nig = WGM * nN, gid = wgid / nig, fm = gid * WGM, gsz = (nM - fm) < WGM ? (nM - fm) : WGM;
        u.pm = fm + ((wgid % nig) % gsz); u.pn = (wgid % nig) / gsz; return true;
    }
    __device__ __forceinline__ void a_ready(const Unit&) const {}
    __device__ __forceinline__ void done(const Unit&) const {}
};

template <class Epi, class Sched, bool SKIPQ = false, int F8SC = 0>
__device__ __forceinline__ void gemm_phase(LAS unsigned char* lds, const Gemm g, const Sched& S, const Epi& E, int wave_id) {
    const int tid = (wave_id << 6) | fresh_lane(), wid = wave_id, lane = tid & 63, wr = wid >> 2, wc = wid & 3, fr = lane & 15, fq = lane >> 4;
    const int K = g.K, nt = K / BK;
    unsigned voffA[2], voffB[2];
#pragma unroll
    for (int i = 0; i < 2; ++i) { int R, C; stage_rc(tid * 16 + i * 8192, R, C); const int Rb = Epi::PERM ? ((R & ~31) + perm32(R & 31)) : R;
        voffA[i] = (unsigned)(R * K + C) * 2u; voffB[i] = (unsigned)(Rb * K + C) * 2u; }
    const size_t kstep = (size_t)(BK * 2);
    const size_t hstep = (size_t)HALF * K * 2;
    const size_t tstep = 2 * hstep;
    const unsigned ldsw = (unsigned)wid * 1024u;
    const int aoff = lds_byte(wr * 64 + fr, fq * 8), boff = lds_byte(wc * 32 + fr, fq * 8);
#define PG8_SA(b, h) (((b) * 2 + (h)) * HTB)
#define PG8_SB(b, h) ((4 + (b) * 2 + (h)) * HTB)
#define PG8_STAGE(bufoff, gbase, voff) do { _Pragma("unroll") for (int _i = 0; _i < 2; ++_i) \
        __builtin_amdgcn_global_load_lds((const unsigned*)((const char*)(gbase) + (voff)[_i]), (LAS unsigned*)(lds + (bufoff) + ldsw + _i * 8192), 16, 0, 0); } while (0)
#define PG8_LDA(dst, b, h) do { _Pragma("unroll") for (int m = 0; m < 4; ++m) dst[m] = __builtin_shufflevector(*(const LAS i32x4_t*)(lds + PG8_SA(b, h) + aoff + m * 2048), *(const LAS i32x4_t*)(lds + PG8_SA(b, h) + aoff + m * 2048 + 1024), 0, 1, 2, 3, 4, 5, 6, 7); } while (0)
#define PG8_LDB(dst, b, h) do { _Pragma("unroll") for (int n = 0; n < 2; ++n) dst[n] = __builtin_shufflevector(*(const LAS i32x4_t*)(lds + PG8_SB(b, h) + boff + n * 2048), *(const LAS i32x4_t*)(lds + PG8_SB(b, h) + boff + n * 2048 + 1024), 0, 1, 2, 3, 4, 5, 6, 7); } while (0)
#define PG8_HALF(v, k) __builtin_bit_cast(bf16x8, __builtin_shufflevector((v), (v), 4 * (k), 4 * (k) + 1, 4 * (k) + 2, 4 * (k) + 3))
#define PG8_MMA(ai, bj, At, Bt) do { __builtin_amdgcn_s_setprio(1); _Pragma("unroll") for (int m = 0; m < 4; ++m) _Pragma("unroll") for (int n = 0; n < ((SKIPQ && (bj) == 1) ? 1 : 2); ++n) { \
        if constexpr (F8SC != 0) asm volatile("v_mfma_scale_f32_16x16x128_f8f6f4 %0, %1, %2, %0, %3, %4 op_sel_hi:[0,0,0]" : "+v"(acc[ai][bj][m][n]) : "v"(Bt[n]), "v"(At[m]), "v"(sclA), "v"(sclB)); \
        else { acc[ai][bj][m][n] = __builtin_amdgcn_mfma_f32_16x16x32_bf16(PG8_HALF(Bt[n], 0), PG8_HALF(At[m], 0), acc[ai][bj][m][n], 0, 0, 0); \
               acc[ai][bj][m][n] = __builtin_amdgcn_mfma_f32_16x16x32_bf16(PG8_HALF(Bt[n], 1), PG8_HALF(At[m], 1), acc[ai][bj][m][n], 0, 0, 0); } } __builtin_amdgcn_s_setprio(0); } while (0)
#define PG8_WAIT_V(n) asm volatile("s_waitcnt vmcnt(" #n ")" ::: "memory")
#define PG8_WAIT_L(n) asm volatile("s_waitcnt lgkmcnt(" #n ")" ::: "memory")
#define PG8_BAR __builtin_amdgcn_s_barrier()
#define PG8_SCHED __builtin_amdgcn_sched_barrier(0)
    Unit cur, nxt; int ui = 0;
    if (!S.next(0, cur)) return;
    int sclA = F8SC * 0x01010101, sclB = 0x7f7f7f7f;
    if constexpr (F8SC != 0) asm volatile("" : "+v"(sclA), "+v"(sclB));
    f32x4 acc[2][2][4][2];
#pragma unroll
    for (int a = 0; a < 2; ++a)
#pragma unroll
        for (int b = 0; b < 2; ++b)
#pragma unroll
            for (int m = 0; m < 4; ++m)
#pragma unroll
                for (int n = 0; n < 2; ++n) acc[a][b][m][n] = (f32x4){0.f, 0.f, 0.f, 0.f};
    i32x8_t At[4], B0[2], B1[2];
    const char* cA = (const char*)g.A + (size_t)cur.pm * tstep; const char* cB = (const char*)g.Bt + (size_t)cur.pn * tstep;
    S.a_ready(cur);
    PG8_STAGE(PG8_SB(0, 0), cB, voffB); PG8_STAGE(PG8_SA(0, 0), cA, voffA); PG8_STAGE(PG8_SB(0, 1), cB + hstep, voffB); PG8_STAGE(PG8_SA(0, 1), cA + hstep, voffA);
    if (wr == 1) PG8_BAR;
    PG8_WAIT_V(4); PG8_BAR;
    PG8_STAGE(PG8_SB(1, 0), cB + kstep, voffB); PG8_STAGE(PG8_SA(1, 0), cA + kstep, voffA); PG8_STAGE(PG8_SB(1, 1), cB + hstep + kstep, voffB);
    PG8_WAIT_V(6); PG8_BAR;
    for (;;) {
        const bool has_next = S.next(ui + 1, nxt);
        const char* nA = has_next ? (const char*)g.A + (size_t)nxt.pm * tstep : cA; const char* nB = has_next ? (const char*)g.Bt + (size_t)nxt.pn * tstep : cB;
#pragma unroll 1
        for (int t = 0; t < nt; t += 2) {
            const bool last = (t == nt - 2);
            const char* a1 = cA + (size_t)(t + 1) * kstep;
            const char* a2 = last ? nA : cA + (size_t)(t + 2) * kstep; const char* b2 = last ? nB : cB + (size_t)(t + 2) * kstep;
            const char* a3 = a2 + kstep; const char* b3 = b2 + kstep;
            if (last && has_next) S.a_ready(nxt);
            PG8_LDB(B0, 0, 0); PG8_SCHED; PG8_LDA(At, 0, 0); PG8_STAGE(PG8_SA(1, 1), a1 + hstep, voffA);
            PG8_WAIT_L(8); PG8_BAR; PG8_WAIT_L(0); PG8_MMA(0, 0, At, B0); PG8_BAR; PG8_SCHED;
            PG8_LDB(B1, 0, 1); PG8_STAGE(PG8_SB(0, 0), b2, voffB);
            PG8_BAR; PG8_WAIT_L(0); PG8_MMA(0, 1, At, B1); PG8_BAR;
            PG8_LDA(At, 0, 1); PG8_STAGE(PG8_SA(0, 0), a2, voffA);
            PG8_BAR; PG8_WAIT_L(0); PG8_MMA(1, 0, At, B0); PG8_BAR; PG8_SCHED;
            PG8_STAGE(PG8_SB(0, 1), b2 + hstep, voffB);
            PG8_WAIT_V(6); PG8_BAR; PG8_MMA(1, 1, At, B1); PG8_BAR;
            PG8_LDB(B0, 1, 0); PG8_SCHED; PG8_LDA(At, 1, 0); PG8_STAGE(PG8_SA(0, 1), a2 + hstep, voffA);
            PG8_WAIT_L(8); PG8_BAR; PG8_WAIT_L(0); PG8_MMA(0, 0, At, B0); PG8_BAR; PG8_SCHED;
            PG8_LDB(B1, 1, 1); PG8_STAGE(PG8_SB(1, 0), b3, voffB);
            PG8_BAR; PG8_WAIT_L(0); PG8_MMA(0, 1, At, B1); PG8_BAR;
            PG8_LDA(At, 1, 1); PG8_STAGE(PG8_SA(1, 0), a3, voffA);
            PG8_BAR; PG8_WAIT_L(0); PG8_MMA(1, 0, At, B0); PG8_BAR; PG8_SCHED;
            PG8_STAGE(PG8_SB(1, 1), b3 + hstep, voffB);
            PG8_WAIT_V(6); PG8_BAR; PG8_MMA(1, 1, At, B1); PG8_BAR;
        }
        if constexpr (F8SC != 0) asm volatile("s_nop 15\n\ts_nop 7" ::: "memory");
        E(acc, cur, wr, wc, fr, fq); S.done(cur);
        if (!has_next) break;
#pragma unroll
        for (int a = 0; a < 2; ++a)
#pragma unroll
            for (int b = 0; b < 2; ++b)
#pragma unroll
                for (int m = 0; m < 4; ++m)
#pragma unroll
                    for (int n = 0; n < 2; ++n) acc[a][b][m][n] = (f32x4){0.f, 0.f, 0.f, 0.f};
        cur = nxt; cA = nA; cB = nB; ++ui;
    }
    PG8_WAIT_V(0);
    if (wr == 0) PG8_BAR;
    PG8_BAR;
#undef PG8_SA
#undef PG8_SB
#undef PG8_STAGE
#undef PG8_LDA
#undef PG8_LDB
#undef PG8_HALF
#undef PG8_MMA
#undef PG8_WAIT_V
#undef PG8_WAIT_L
#undef PG8_BAR
#undef PG8_SCHED
}
}

__device__ __forceinline__ unsigned cvt_pk_bf16(float lo, float hi) { unsigned r; asm volatile("v_cvt_pk_bf16_f32 %0, %1, %2" : "=v"(r) : "v"(lo), "v"(hi)); return r; }

struct EpiRoute {
    static constexpr bool PERM = true;
    unsigned char* ws; int mode; bf16_t* O; int ldc; int pn0 = 0;
    __device__ __forceinline__ void operator()(const f32x4 (&acc)[2][2][4][2], const pg8::Unit& u, int wr, int wc, int fr, int fq) const {
        const int row0 = u.pm * 256 + wr * 64 + fr;
        bf16_t* base; int ld, colt; bool gelu = false;
        if (mode == 0) {
            const int pn = u.pn + pn0;
            if (pn < 4) { base = (bf16_t*)(ws + WS_LX); ld = 1024; colt = pn * 256; }
            else if (pn < 8) { base = (bf16_t*)(ws + WS_GG); ld = 1024; colt = (pn - 4) * 256; gelu = true; }
            else if (pn < 12) { base = (bf16_t*)(ws + WS_Q); ld = 1024; colt = (pn - 8) * 256; }
            else if (pn < 16) { base = (bf16_t*)(ws + WS_MQ); ld = 1024; colt = (pn - 12) * 256; }
            else if (pn == 16) { base = (bf16_t*)(ws + WS_KR); ld = 256; colt = 0; }
            else if (pn == 17) { base = (bf16_t*)(ws + WS_V); ld = 256; colt = 0; }
            else if (pn < 20) { base = (bf16_t*)(ws + WS_QI); ld = 512; colt = (pn - 18) * 256; }
            else { base = (bf16_t*)(ws + WS_KW); ld = 256; colt = 0; }
        } else { base = O; ld = ldc; colt = u.pn * 256; }
        const int col0 = colt + wc * 32 + 8 * fq;
#pragma unroll
        for (int ai = 0; ai < 2; ++ai)
#pragma unroll
            for (int m = 0; m < 4; ++m) { bf16_t* rowp = base + (size_t)(row0 + ai * 128 + m * 16) * ld + col0;
#pragma unroll
                for (int bj = 0; bj < 2; ++bj) { f32x4 v0 = acc[ai][bj][m][0], v1 = acc[ai][bj][m][1];
                    if (gelu) {
#pragma unroll
                        for (int j = 0; j < 4; ++j) { v0[j] = gelu_tanh(v0[j]); v1[j] = gelu_tanh(v1[j]); } }
                    u32x4 w; w.x = cvt_pk_bf16(v0[0], v0[1]); w.y = cvt_pk_bf16(v0[2], v0[3]); w.z = cvt_pk_bf16(v1[0], v1[1]); w.w = cvt_pk_bf16(v1[2], v1[3]);
                    *(u32x4*)(rowp + bj * 128) = w; } }
    }
};

struct EpiMerge {
    static constexpr bool PERM = false;
    const bf16_t* Y0; const bf16_t* Y1; const bf16_t* Y2; bf16_t* MG;
    __device__ __forceinline__ void operator()(const f32x4 (&acc)[2][2][4][2], const pg8::Unit& u, int wr, int wc, int fr, int fq) const {
        const unsigned ch = (unsigned)(u.pn * 64 + wc * 16 + fq * 4);
        const unsigned off0 = (unsigned)(u.pm * 256 + wr * 64 + fr) * 1024u + ch;
        u32x2 y0[2][4], y1[2][4], y2[2][4];
#pragma unroll
        for (int ai = 0; ai < 2; ++ai)
#pragma unroll
            for (int m = 0; m < 4; ++m) { const unsigned off = off0 + (unsigned)(ai * 128 + m * 16) * 1024u;
                y0[ai][m] = *(const u32x2*)(Y0 + off); y1[ai][m] = *(const u32x2*)(Y1 + off); y2[ai][m] = *(const u32x2*)(Y2 + off); }
#pragma unroll
        for (int ai = 0; ai < 2; ++ai)
#pragma unroll
            for (int m = 0; m < 4; ++m) {
                const unsigned off = off0 + (unsigned)(ai * 128 + m * 16) * 1024u;
                const u32x2 a = y0[ai][m], b = y1[ai][m], c = y2[ai][m];
                const f32x4 g0 = acc[ai][0][m][0], g1 = acc[ai][0][m][1], g2 = acc[ai][1][m][0];
                float o[4];
                o[0] = sigmoidf_(g0[0]) * bflo(a.x) + sigmoidf_(g1[0]) * bflo(b.x) + sigmoidf_(g2[0]) * bflo(c.x);
                o[1] = sigmoidf_(g0[1]) * bfhi(a.x) + sigmoidf_(g1[1]) * bfhi(b.x) + sigmoidf_(g2[1]) * bfhi(c.x);
                o[2] = sigmoidf_(g0[2]) * bflo(a.y) + sigmoidf_(g1[2]) * bflo(b.y) + sigmoidf_(g2[2]) * bflo(c.y);
                o[3] = sigmoidf_(g0[3]) * bfhi(a.y) + sigmoidf_(g1[3]) * bfhi(b.y) + sigmoidf_(g2[3]) * bfhi(c.y);
                u32x2 w; w.x = pk2(o[0], o[1]); w.y = pk2(o[2], o[3]);
                *(u32x2*)(MG + off) = w;
            }
    }
};

struct EpiOut {
    static constexpr bool PERM = false;
    const float* X; float* OUT;
    __device__ __forceinline__ void operator()(const f32x4 (&acc)[2][2][4][2], const pg8::Unit& u, int wr, int wc, int fr, int fq) const {
        const unsigned off0 = (unsigned)(u.pm * 256 + wr * 64 + fr) * 1024u + (unsigned)(u.pn * 256 + wc * 32 + 4 * fq);
#pragma unroll
        for (int ai = 0; ai < 2; ++ai) {
            f32x4 xv[4][2][2];
#pragma unroll
            for (int m = 0; m < 4; ++m)
#pragma unroll
                for (int bj = 0; bj < 2; ++bj)
#pragma unroll
                    for (int n = 0; n < 2; ++n) xv[m][bj][n] = *(const f32x4*)(X + (off0 + (unsigned)(ai * 128 + m * 16) * 1024u + (unsigned)(bj * 128 + n * 16)));
#pragma unroll
            for (int m = 0; m < 4; ++m)
#pragma unroll
                for (int bj = 0; bj < 2; ++bj)
#pragma unroll
                    for (int n = 0; n < 2; ++n) *(f32x4*)(OUT + (off0 + (unsigned)(ai * 128 + m * 16) * 1024u + (unsigned)(bj * 128 + n * 16))) = xv[m][bj][n] + acc[ai][bj][m][n];
        }
    }
};

template <class Ld>
__device__ __forceinline__ void transpose_item(const Ld& ld, bf16_t* WT, int Kd, int k0, int n0, LAS float* scr, int lane) {
    float tv[32];
#pragma unroll
    for (int i = 0; i < 32; ++i) tv[i] = ld(k0 + 2 * i + (lane >> 5), n0 + (lane & 31));
#pragma unroll
    for (int i = 0; i < 32; ++i) scr[(2 * i + (lane >> 5)) * 33 + (lane & 31)] = tv[i];
    LDS_WAIT();
    const int c = lane & 7;
#pragma unroll
    for (int j = 0; j < 4; ++j) { const int n = (lane >> 3) + 8 * j; const LAS float* s = scr + (8 * c) * 33 + n;
        u32x4 o; o.x = pk2(s[0 * 33], s[1 * 33]); o.y = pk2(s[2 * 33], s[3 * 33]); o.z = pk2(s[4 * 33], s[5 * 33]); o.w = pk2(s[6 * 33], s[7 * 33]);
        *(u32x4*)(WT + (size_t)(n0 + n) * Kd + k0 + 8 * c) = o; }
    LDS_WAIT();
}
__device__ __forceinline__ unsigned pk4_fp8(float a, float b, float c, float d, float sc) {
    int w = 0; w = __builtin_amdgcn_cvt_pk_fp8_f32(__builtin_amdgcn_fmed3f(a * sc, -448.f, 448.f), __builtin_amdgcn_fmed3f(b * sc, -448.f, 448.f), w, false);
    w = __builtin_amdgcn_cvt_pk_fp8_f32(__builtin_amdgcn_fmed3f(c * sc, -448.f, 448.f), __builtin_amdgcn_fmed3f(d * sc, -448.f, 448.f), w, true); return (unsigned)w; }
template <class Ld>
__device__ __forceinline__ void transpose_item_f8(const Ld& ld, unsigned char* WT, int Kd, int k0, int n0, LAS float* scr, int lane, float sc) {
    float tv[32];
#pragma unroll
    for (int i = 0; i < 32; ++i) tv[i] = ld(k0 + 2 * i + (lane >> 5), n0 + (lane & 31));
#pragma unroll
    for (int i = 0; i < 32; ++i) scr[(2 * i + (lane >> 5)) * 33 + (lane & 31)] = tv[i];
    LDS_WAIT();
    const int c = lane & 7;
#pragma unroll
    for (int j = 0; j < 4; ++j) { const int n = (lane >> 3) + 8 * j; const LAS float* s = scr + (8 * c) * 33 + n;
        u32x2 o; o.x = pk4_fp8(s[0 * 33], s[1 * 33], s[2 * 33], s[3 * 33], sc); o.y = pk4_fp8(s[4 * 33], s[5 * 33], s[6 * 33], s[7 * 33], sc);
        *(u32x2*)(WT + (size_t)(n0 + n) * Kd + k0 + 8 * c) = o; }
    LDS_WAIT();
}
__device__ __forceinline__ void rms_row_to_fp8(const float* xbase, const float* gain, unsigned char* obase, bf16_t* bbase, int m, int lane, float sc) {
    const f32x4* gr = (const f32x4*)gain + lane; const f32x4* xr = (const f32x4*)(xbase + (size_t)m * 1024) + lane;
    f32x4 v[4], g[4];
#pragma unroll
    for (int j = 0; j < 4; ++j) v[j] = xr[64 * j];
#pragma unroll
    for (int j = 0; j < 4; ++j) g[j] = gr[64 * j];
    float s = 0.f;
#pragma unroll
    for (int j = 0; j < 4; ++j) s += (v[j].x * v[j].x + v[j].y * v[j].y) + (v[j].z * v[j].z + v[j].w * v[j].w);
    const float rstd = rsqrtf(wave_sum(s) * (1.f / 1024.f) + EPS) * sc;
    unsigned* o4 = (unsigned*)(obase + (size_t)m * 1024) + lane;
#pragma unroll
    for (int j = 0; j < 4; ++j) o4[64 * j] = pk4_fp8(v[j].x * g[j].x, v[j].y * g[j].y, v[j].z * g[j].z, v[j].w * g[j].w, rstd);
    if (bbase) { const float rs = rstd * (1.0f / sc); u32x2* o8 = (u32x2*)(bbase + (size_t)m * 1024) + lane;
#pragma unroll
        for (int j = 0; j < 4; ++j) { u32x2 w; w.x = pk2(v[j].x * rs * g[j].x, v[j].y * rs * g[j].y); w.y = pk2(v[j].z * rs * g[j].z, v[j].w * rs * g[j].w); o8[64 * j] = w; } }
}
template <int NB, int NQ = 0> __device__ __forceinline__ void rms_rows_to_bf16(const float* xbase, const float* gain, bf16_t* obase, int m0, int mstride, int mlimit, int lane) {
    const f32x4* gr = (const f32x4*)gain + lane;
    f32x4 v[NB][4]; int mk[NB];
#pragma unroll
    for (int k = 0; k < NB; ++k) { const int m = m0 + k * mstride < mlimit ? m0 + k * mstride : m0; mk[k] = m; const f32x4* xr = (const f32x4*)(xbase + (size_t)m * 1024) + lane;
#pragma unroll
        for (int j = 0; j < 4; ++j) v[k][j] = xr[64 * j]; }
    f32x4 g[4];
#pragma unroll
    for (int j = 0; j < 4; ++j) g[j] = gr[64 * j];
#pragma unroll
    for (int k = 0; k < NB; ++k) { float s = 0.f;
#pragma unroll
        for (int j = 0; j < 4; ++j) s += (v[k][j].x * v[k][j].x + v[k][j].y * v[k][j].y) + (v[k][j].z * v[k][j].z + v[k][j].w * v[k][j].w);
        const float rstd = rsqrtf(wave_sum(s) * (1.f / 1024.f) + EPS);
        u32x2* o8 = (u32x2*)(obase + (size_t)mk[k] * 1024) + lane;
#pragma unroll
        for (int j = 0; j < 4; ++j) { float a0 = v[k][j].x * rstd * g[j].x, a1 = v[k][j].y * rstd * g[j].y, a2 = v[k][j].z * rstd * g[j].z, a3 = v[k][j].w * rstd * g[j].w;
            if (NQ) { a0 = __uint_as_float((__float_as_uint(a0) + 0x00020000u) & 0xFFFC0000u); a1 = __uint_as_float((__float_as_uint(a1) + 0x00020000u) & 0xFFFC0000u); a2 = __uint_as_float((__float_as_uint(a2) + 0x00020000u) & 0xFFFC0000u); a3 = __uint_as_float((__float_as_uint(a3) + 0x00020000u) & 0xFFFC0000u); }
            u32x2 w; w.x = pk2(a0, a1); w.y = pk2(a2, a3); o8[64 * j] = w; } }
}

__device__ __forceinline__ void phase_prologue(const Params& p, LAS unsigned char* lds, int lane, int wave, int gw, int NGW) {
    LAS float* scr = (LAS float*)(lds + wave * 16384);
    unsigned char* ws = p.ws;
    constexpr int I_W1 = 16 * (N1 / 32), I_WG = 16 * (NGATE / 32), I_WO = 16 * 32, I_WKV = 16 * 64, I_WQ = 16 * 64, I_LRU = 16 * 2 * 2;
    constexpr int NITEMS = I_W1 + I_WG + I_WO + I_WKV + I_WQ + I_LRU;
#ifndef PDUP
#define PDUP 0
#endif
#pragma unroll 1
    for (int rep_ = 0; rep_ < (PDUP == 1 ? 2 : 1); ++rep_)
    for (int it = gw; it < NITEMS; it += NGW) {
        int r = it;
        if (r < I_W1) { const int kb = r / (N1 / 32), nb = r % (N1 / 32); const float* W = p.w_in;
            auto ld = [W](int k, int n) -> float { int sc; if (n < 3072) sc = n; else if (n < 4096) sc = n + 1096; else if (n < 5192) sc = n - 1024; else sc = -1; return sc >= 0 ? W[(size_t)k * 8264 + sc] : 0.f; };
            if (nb < N1F / 32) transpose_item_f8(ld, ws + WS_W1T, 1024, kb * 64, nb * 32, scr, lane, W8_SCALE);
            else { auto ld2 = [&ld](int k, int n) -> float { return ld(k, n + N1F); }; transpose_item(ld2, (bf16_t*)(ws + WS_W1TB), 1024, kb * 64, nb * 32 - N1F, scr, lane); }
            continue; } r -= I_W1;
        if (r < I_WG) { const int kb = r / (NGATE / 32), nb = r % (NGATE / 32); const float* W = p.w_in;
            auto ld = [W](int k, int R) -> float { const int pn = R >> 8, bj = (R >> 7) & 1, wc = (R >> 5) & 3, n = (R >> 4) & 1, lo = R & 15; const int br = 2 * bj + n, ch = 64 * pn + 16 * wc + lo;
                return br < 3 ? W[(size_t)k * 8264 + 5192 + 1024 * br + ch] : 0.f; };
            transpose_item_f8(ld, ws + WS_WGT, 1024, kb * 64, nb * 32, scr, lane, W8_SCALE); continue; } r -= I_WG;
        if (r < I_WO) { const int kb = r / 32, nb = r % 32; const float* W = p.w_out;
            auto ld = [W](int k, int n) -> float { return W[(size_t)k * 1024 + n]; };
            transpose_item(ld, (bf16_t*)(ws + WS_WOT), 1024, kb * 64, nb * 32, scr, lane); continue; } r -= I_WO;
        if (r < I_WKV) { const int kb = r / 64, nb = r % 64; const float* W = p.w_mem_kv;
            auto ld = [W](int k, int n) -> float { return W[(size_t)k * 2048 + n]; };
            transpose_item(ld, (bf16_t*)(ws + WS_WKVT), 1024, kb * 64, nb * 32, scr, lane); continue; } r -= I_WKV;
        if (r < I_WQ) { const int kb = r / 64, nb = r % 64; const float* W = p.peer_wq;
            auto ld = [W](int k, int n) -> float { return W[(size_t)k * 2048 + n]; };
            transpose_item(ld, (bf16_t*)(ws + WS_WQT), 1024, kb * 64, nb * 32, scr, lane); continue; } r -= I_WQ;
        { const int which = r >> 5, blk = (r >> 1) & 15, nb = r & 1; const float* W = (which ? p.lru_wi : p.lru_wa) + blk * 4096;
            auto ld = [W](int k, int n) -> float { return W[k * 64 + n]; };
            transpose_item(ld, (bf16_t*)(ws + (which ? WS_WIT : WS_WAT)) + blk * 4096, 64, 0, nb * 32, scr, lane); }
    }
    { float* C = (float*)(ws + WS_CONST);
      for (int i = gw * 64 + lane; i < C_END; i += NGW * 64) { float v;
          if (i < C_CONVB) v = p.conv_w[i]; else if (i < C_LBA) v = p.conv_b[i - C_CONVB]; else if (i < C_LBI) v = p.lru_ba[i - C_LBA]; else if (i < C_LAM) v = p.lru_bi[i - C_LBI];
          else if (i < C_QN) v = p.lru_lambda[i - C_LAM]; else if (i < C_KN) v = p.q_norm[i - C_QN]; else if (i < C_IKN) v = p.k_norm[i - C_KN]; else if (i < C_MQN) v = p.idx_k_norm[i - C_IKN];
          else if (i < C_MKN) v = p.mem_q_norm[i - C_MQN]; else if (i < C_NFFN) v = p.mem_k_norm[i - C_MKN]; else v = p.norm_ffn[i - C_NFFN];
          C[i] = v; } }
    { const float* S = p.peer_subkeys; bf16_t* D = (bf16_t*)(ws + WS_SUBK);
      for (int i = gw * 64 + lane; i < 262144 / 4; i += NGW * 64) { const f32x4 v = ((const f32x4*)S)[i]; u32x2 w; w.x = pk2(v.x, v.y); w.y = pk2(v.z, v.w); ((u32x2*)D)[i] = w; } }
    { f32x2* R64 = (f32x2*)(ws + WS_ROPE64); f32x2* R32 = (f32x2*)(ws + WS_ROPE32);
#pragma unroll 1
      for (int rep_ = 0; rep_ < (PDUP == 3 ? 2 : 1); ++rep_)
      for (int e = gw * 64 + lane; e < 4096 * 96; e += NGW * 64) {
          const int pos = e / 96, i = e % 96; const bool is64 = i < 64; const int ii = is64 ? i : i - 64; const float half = is64 ? 64.f : 32.f;
          const float freq = exp2f(-(float)ii / half * 13.287712379549449f);
          const float angf = (float)pos * freq;
          const double a = (double)angf; const double kq = rint(a * 0.15915494309189535); const float rr = (float)(a - kq * 6.283185307179586);
          f32x2 cs; cs.x = __cosf(rr); cs.y = __sinf(rr);
          if (is64) R64[pos * 64 + ii] = cs; else R32[pos * 32 + ii] = cs; } }
#pragma unroll 1
    for (int rep_ = 0; rep_ < (PDUP == 2 ? 2 : 1); ++rep_)
    for (int m = gw; m < T_TOK; m += NGW) rms_row_to_fp8(p.x, p.norm_mix, ws + WS_XN, (bf16_t*)p.out, m, lane, X8_SCALE);
    for (int m = gw; m < NBATCH * MEMT; m += NGW) rms_rows_to_bf16<1>(p.mem, p.mem_norm, (bf16_t*)(ws + WS_MN), m, NGW, NBATCH * MEMT, lane);
}

template <int NB> __device__ __forceinline__ void kprep_tokens(const Params& p, int t0, int tstride, int lane) {
    unsigned char* ws = p.ws;
    const int g = lane >> 5, i = lane & 31, d = lane & 31;
    int tk[NB]; unsigned u0[NB], u1[NB]; float kx[NB], ky[NB]; f32x4 cs64[NB]; f32x2 cs32[NB];
    const float* C = (const float*)(ws + WS_CONST);
    const f32x2 ga = *(const f32x2*)(C + C_KN + 2 * i), gb = *(const f32x2*)(C + C_KN + 64 + 2 * i);
    const float gi0 = C[C_IKN + d], gi1 = C[C_IKN + d + 32];
#pragma unroll
    for (int k = 0; k < NB; ++k) { const int t = t0 + k * tstride < T_TOK ? t0 + k * tstride : t0; tk[k] = t; const int pos = t & (SEQ - 1);
        const bf16_t* src = (const bf16_t*)(ws + WS_KR) + (size_t)t * 256 + g * 128 + 2 * i; u0[k] = *(const unsigned*)src; u1[k] = *(const unsigned*)(src + 64);
        const bf16_t* sw = (const bf16_t*)(ws + WS_KW) + (size_t)t * 256; kx[k] = bf2f(sw[d]); ky[k] = bf2f(sw[d + 32]);
        cs64[k] = *(const f32x4*)((const float*)(ws + WS_ROPE64) + ((size_t)pos * 64 + 2 * i) * 2);
        cs32[k] = *(const f32x2*)((const float*)(ws + WS_ROPE32) + ((size_t)pos * 32 + d) * 2); }
#pragma unroll
    for (int k = 0; k < NB; ++k) {
        const int t = tk[k];
        {
            float x0 = bflo(u0[k]), x1 = bfhi(u0[k]), y0 = bflo(u1[k]), y1 = bfhi(u1[k]);
            float ss = x0 * x0 + x1 * x1 + y0 * y0 + y1 * y1;
#pragma unroll
            for (int o = 1; o < 32; o <<= 1) ss += __shfl_xor(ss, o);
            const float rstd = rsqrtf(ss * (1.f / 128.f) + EPS);
            x0 *= rstd * ga.x; x1 *= rstd * ga.y; y0 *= rstd * gb.x; y1 *= rstd * gb.y;
            const f32x4 cs = cs64[k];
            const float ox0 = x0 * cs.x - y0 * cs.y, oy0 = y0 * cs.x + x0 * cs.y, ox1 = x1 * cs.z - y1 * cs.w, oy1 = y1 * cs.z + x1 * cs.w;
            unsigned char* d8 = ws + WS_K8 + (size_t)t * 256 + g * 128 + 2 * i;
            const int w0 = __builtin_amdgcn_cvt_pk_fp8_f32(ox0 * K8_SCALE, ox1 * K8_SCALE, 0, false), w1 = __builtin_amdgcn_cvt_pk_fp8_f32(oy0 * K8_SCALE, oy1 * K8_SCALE, 0, false);
            *(unsigned short*)d8 = (unsigned short)w0; *(unsigned short*)(d8 + 64) = (unsigned short)w1;
        }
        {
            float x = kx[k], y = ky[k];
            float ss = x * x + y * y;
#pragma unroll
            for (int o = 1; o < 32; o <<= 1) ss += __shfl_xor(ss, o);
            const float rstd = rsqrtf(ss * (1.f / 64.f) + EPS);
            x *= rstd * gi0; y *= rstd * gi1;
            const f32x2 cs = cs32[k];
            const float ox = x * cs.x - y * cs.y, oy = y * cs.x + x * cs.y;
            bf16_t* dst = (bf16_t*)(ws + WS_KIN) + (size_t)(t >> 4) * 1024 + ((d >> 3) & 3) * 128 + (t & 15) * 8 + (d & 7);
            if (lane < 32) { dst[0] = (bf16_t)f2bf(ox); dst[512] = (bf16_t)f2bf(oy); }
        }
    }
}
__device__ __forceinline__ void mkprep_token(const Params& p, int m, int lane) {
    unsigned char* ws = p.ws;
    const int hd = lane >> 4, e0 = (lane & 15) * 16;
    const bf16_t* src = (const bf16_t*)(ws + WS_MKV) + (size_t)m * 2048 + hd * 256 + e0;
    float v[16]; unpack8(*(const u32x4*)src, v); unpack8(*(const u32x4*)(src + 8), v + 8);
    float ss = 0.f;
#pragma unroll
    for (int j = 0; j < 16; ++j) ss += v[j] * v[j];
#pragma unroll
    for (int o = 1; o < 16; o <<= 1) ss += __shfl_xor(ss, o);
    const float rstd = rsqrtf(ss * (1.f / 256.f) + EPS);
#pragma unroll
    for (int j = 0; j < 16; ++j) v[j] *= rstd * ((const float*)(ws + WS_CONST))[C_MKN + e0 + j];
    bf16_t* dst = (bf16_t*)(ws + WS_MKN) + (size_t)m * 1024 + hd * 256 + e0;
    *(bf16x8*)dst = pack8(v); *(bf16x8*)(dst + 8) = pack8(v + 8);
}

constexpr int LRU_WLDS = 19456;
template <bool APPLY>
__device__ __forceinline__ void lru_item(const Params& p, LAS unsigned char* wlds, int item, int lane) {
    unsigned char* ws = p.ws;
    const int ck = item >> 4, nblk = item & 15, t0 = ck * 128, c0 = nblk * 64;
    const bool first = (ck & 31) == 0;
    const int row = lane & 15, grp = lane >> 4;
    const bf16_t* LX = (const bf16_t*)(ws + WS_LX);
#pragma unroll
    for (int i = 0; i < 17; ++i) { const int r = (lane >> 3) + 8 * i;
        if (r < 131) { u32x4 v = (u32x4){0u, 0u, 0u, 0u};
            if (!(first && r < 3)) v = *(const u32x4*)(LX + (size_t)(t0 - 3 + r) * 1024 + c0 + (lane & 7) * 8);
            *(LAS u32x4*)(wlds + r * 144 + (lane & 7) * 16) = v; } }
    LDS_WAIT();
    {
        const float w0 = ((const float*)(ws + WS_CONST))[C_CONVW + 0 * 1024 + c0 + lane], w1 = ((const float*)(ws + WS_CONST))[C_CONVW + 1 * 1024 + c0 + lane], w2 = ((const float*)(ws + WS_CONST))[C_CONVW + 2 * 1024 + c0 + lane], w3 = ((const float*)(ws + WS_CONST))[C_CONVW + 3 * 1024 + c0 + lane], cb = ((const float*)(ws + WS_CONST))[C_CONVB + c0 + lane];
        LAS bf16_t* col = (LAS bf16_t*)wlds + lane;
        float xa = bf2f(col[130 * 72]), xb = bf2f(col[129 * 72]), xcc = bf2f(col[128 * 72]);
#pragma unroll 8
        for (int t = 127; t >= 0; --t) { const float xd = bf2f(col[t * 72]);
            const float y = cb + w3 * xa + w2 * xb + w1 * xcc + w0 * xd;
            col[(t + 3) * 72] = (bf16_t)f2bf(y);
            xa = xb; xb = xcc; xcc = xd; }
    }
    LDS_WAIT();
    bf16x8 wa[4][2], wi[4][2];
    {
        const bf16_t* WA = (const bf16_t*)(ws + WS_WAT) + nblk * 4096; const bf16_t* WI = (const bf16_t*)(ws + WS_WIT) + nblk * 4096;
#pragma unroll
        for (int nt = 0; nt < 4; ++nt)
#pragma unroll
            for (int ks = 0; ks < 2; ++ks) { const int o = (16 * nt + row) * 64 + 32 * ks + 8 * grp; wa[nt][ks] = *(const bf16x8*)(WA + o); wi[nt][ks] = *(const bf16x8*)(WI + o); }
    }
    float ba[4], bi[4], sp[4], hc[4], atot[4];
#pragma unroll
    for (int nt = 0; nt < 4; ++nt) { const int d = c0 + 16 * nt + row; ba[nt] = ((const float*)(ws + WS_CONST))[C_LBA + d]; bi[nt] = ((const float*)(ws + WS_CONST))[C_LBI + d];
        sp[nt] = 8.0f * log1pf(__expf(-((const float*)(ws + WS_CONST))[C_LAM + d])); hc[nt] = 0.f; atot[nt] = 1.f; }
    if (APPLY) {
        const f32x2* SU = (const f32x2*)(ws + WS_LRUS);
        const int cb0 = ck & ~31;
        for (int j = cb0; j < ck; ++j) {
#pragma unroll
            for (int nt = 0; nt < 4; ++nt) { const f32x2 s = SU[(size_t)j * 1024 + c0 + 16 * nt + row]; hc[nt] = s.x * hc[nt] + s.y; } }
    }
    for (int mt = 0; mt < 8; ++mt) {
        const LAS unsigned char* arow = wlds + (16 * mt + 3 + row) * 144 + 16 * grp;
        const bf16x8 a0 = *(const LAS bf16x8*)arow, a1 = *(const LAS bf16x8*)(arow + 64);
#pragma unroll
        for (int nt = 0; nt < 4; ++nt) {
            f32x4 ca = (f32x4){0.f, 0.f, 0.f, 0.f}, ci = (f32x4){0.f, 0.f, 0.f, 0.f};
            ca = MFMA16(a0, wa[nt][0], ca); ca = MFMA16(a1, wa[nt][1], ca);
            ci = MFMA16(a0, wi[nt][0], ci); ci = MFMA16(a1, wi[nt][1], ci);
            LAS bf16_t* slot = (LAS bf16_t*)(wlds + (16 * mt + 3 + 4 * grp) * 144) + 16 * nt + row;
            float A = 1.f, U = 0.f, hl[4], ap[4];
#pragma unroll
            for (int reg = 0; reg < 4; ++reg) {
                const float r = sigmoidf_(ca[reg] + ba[nt]), ig = sigmoidf_(ci[reg] + bi[nt]);
                const float la = -r * sp[nt];
                const float a = __expf(la), mult = __builtin_amdgcn_sqrtf(fmaxf(1.0f - a * a, 0.f));
                const float u = mult * ig * bf2f(slot[reg * 72]);
                U = a * U + u; A *= a; hl[reg] = U; ap[reg] = A;
            }
            const float A0 = __shfl(A, row), U0 = __shfl(U, row), A1 = __shfl(A, 16 + row), U1 = __shfl(U, 16 + row);
            const float A2 = __shfl(A, 32 + row), U2 = __shfl(U, 32 + row), A3 = __shfl(A, 48 + row), U3 = __shfl(U, 48 + row);
            const float h0 = hc[nt], h1 = A0 * h0 + U0, h2 = A1 * h1 + U1, h3 = A2 * h2 + U2, h4 = A3 * h3 + U3;
            if (!APPLY) {
                const float hin = grp == 0 ? h0 : (grp == 1 ? h1 : (grp == 2 ? h2 : h3));
                const float pg = grp == 0 ? 1.f : (grp == 1 ? A0 : (grp == 2 ? A0 * A1 : A0 * A1 * A2));
                const float apre = atot[nt] * pg;
                unsigned* HA = (unsigned*)p.out;
                const unsigned ho = (unsigned)(t0 + 16 * mt + 4 * grp) * 1024u + (unsigned)(c0 + 16 * nt + row);
#pragma unroll
                for (int reg = 0; reg < 4; ++reg) HA[ho + 1024u * reg] = pk2(hl[reg] + ap[reg] * hin, apre * ap[reg]);
            }
            hc[nt] = h4; atot[nt] *= (A0 * A1) * (A2 * A3);
            if (APPLY) {
                const float hin = grp == 0 ? h0 : (grp == 1 ? h1 : (grp == 2 ? h2 : h3));
#pragma unroll
                for (int reg = 0; reg < 4; ++reg) slot[reg * 72] = (bf16_t)f2bf(hl[reg] + ap[reg] * hin);
            }
        }
    }
    if (!APPLY) {
        if (grp == 0) { f32x2* SU = (f32x2*)(ws + WS_LRUS);
#pragma unroll
            for (int nt = 0; nt < 4; ++nt) { f32x2 s; s.x = atot[nt]; s.y = hc[nt]; SU[(size_t)ck * 1024 + c0 + 16 * nt + row] = s; } }
    } else {
        LDS_WAIT();
        bf16_t* GG = (bf16_t*)(ws + WS_GG);
#pragma unroll 4
        for (int i = 0; i < 16; ++i) { const int r = (lane >> 3) + 8 * i;
            float hv[8], gv[8];
            unpack8(*(const LAS u32x4*)(wlds + (r + 3) * 144 + (lane & 7) * 16), hv);
            bf16_t* gp = GG + (size_t)(t0 + r) * 1024 + c0 + (lane & 7) * 8;
            unpack8(*(const u32x4*)gp, gv);
#pragma unroll
            for (int j = 0; j < 8; ++j) hv[j] *= gv[j];
            *(bf16x8*)gp = pack8(hv); }
    }
    LDS_WAIT();
}

__device__ __forceinline__ void lru_apply_item(const Params& p, int item, int lane) {
    unsigned char* ws = p.ws;
    const int ck = item >> 3, cq = item & 3, th = (item >> 2) & 1;
    const unsigned c = (unsigned)(cq * 256 + 4 * lane);
    float hin[4] = {0.f, 0.f, 0.f, 0.f};
    { const f32x4* SU = (const f32x4*)(ws + WS_LRUS);
      for (int j = ck & ~31; j < ck; ++j) { const f32x4 s0 = SU[((size_t)j * 1024 + c) >> 1], s1 = SU[(((size_t)j * 1024 + c) >> 1) + 1];
          hin[0] = s0.x * hin[0] + s0.y; hin[1] = s0.z * hin[1] + s0.w; hin[2] = s1.x * hin[2] + s1.y; hin[3] = s1.z * hin[3] + s1.w; } }
    const unsigned* HA = (const unsigned*)p.out; bf16_t* GG = (bf16_t*)(ws + WS_GG);
    const unsigned base = (unsigned)(ck * 128 + th * 64) * 1024u + c;
#pragma unroll 8
    for (int r = 0; r < 64; ++r) {
        const u32x4 ha = *(const u32x4*)(HA + base + 1024u * r); const u32x2 gg = *(const u32x2*)(GG + base + 1024u * r);
        const float y0 = (bflo(ha.x) + bfhi(ha.x) * hin[0]) * bflo(gg.x), y1 = (bflo(ha.y) + bfhi(ha.y) * hin[1]) * bfhi(gg.x);
        const float y2 = (bflo(ha.z) + bfhi(ha.z) * hin[2]) * bflo(gg.y), y3 = (bflo(ha.w) + bfhi(ha.w) * hin[3]) * bfhi(gg.y);
        u32x2 w; w.x = pk2(y0, y1); w.y = pk2(y2, y3);
        *(u32x2*)(GG + base + 1024u * r) = w;
    }
}

constexpr int SC_STRIDE = 4100;
constexpr int IDX_SC_BYTES = 8 * SC_STRIDE * 4;
constexpr int IDX_SEL_OFF = IDX_SC_BYTES;

__device__ __forceinline__ float wave_max(float v) {
#pragma unroll
    for (int o = 1; o < 64; o <<= 1) v = fmaxf(v, __shfl_xor(v, o));
    return v;
}
__device__ __forceinline__ float wave_min(float v) {
#pragma unroll
    for (int o = 1; o < 64; o <<= 1) v = fminf(v, __shfl_xor(v, o));
    return v;
}
__device__ __forceinline__ unsigned wave_excl_scan(unsigned v, int lane) {
    unsigned s = v;
#pragma unroll
    for (int o = 1; o < 64; o <<= 1) { const unsigned t = __shfl_up(s, o); if (lane >= o) s += t; }
    return s - v;
}

constexpr int SEL_CAP = 128, SEL_HIST_B = 1056, SEL_CAND_B = 1040, SEL_OUT_B = 528, SEL_WLDS = SEL_HIST_B + SEL_CAND_B + SEL_OUT_B;
__device__ __forceinline__ int sel_bin(float x, float lo, float scale) { int b = (int)((x - lo) * scale); b = b > 255 ? 255 : b; b = b < 0 ? 0 : b; return b; }
__device__ __forceinline__ unsigned lane_rank(unsigned long long mask) { return __builtin_amdgcn_mbcnt_hi((unsigned)(mask >> 32), __builtin_amdgcn_mbcnt_lo((unsigned)mask, 0u)); }
__device__ __forceinline__ void select_top256(LAS float* rowp, int n, bf16_t* out, LAS unsigned char* wl, int lane) {
    LAS unsigned* hist = (LAS unsigned*)wl; LAS u32x2* cand = (LAS u32x2*)(wl + SEL_HIST_B); LAS bf16_t* outl = (LAS bf16_t*)(wl + SEL_HIST_B + SEL_CAND_B);
    const int imax4 = (((n + 255) >> 8) + 3) & ~3;
    LAS float* myp = rowp + 4 * lane;
    for (int i = n >> 8; i < imax4; ++i) { f32x4 x = *(LAS f32x4*)(myp + 256 * i);
#pragma unroll
        for (int j = 0; j < 4; ++j) x[j] = (256 * i + 4 * lane + j) < n ? x[j] : -INFINITY;
        *(LAS f32x4*)(myp + 256 * i) = x; }
    float lmx, lmn;
    { const f32x4 x = *(LAS f32x4*)myp; lmx = fmaxf(fmaxf(x[0], x[1]), fmaxf(x[2], x[3])); lmn = fminf(fminf(x[0], x[1]), fminf(x[2], x[3])); }
    *(LAS u32x2*)(outl + 4 * lane) = (u32x2){0u, 0u};
    int need = 256, base = 0; unsigned m = 0;
#pragma unroll 1
    for (int round = 0; round < 6; ++round) {
        const float hi = wave_max(lmx), lo = wave_min(lmn);
        const float scale = (hi > lo) ? 255.0f / (hi - lo) : 0.f;
        *(LAS u32x4*)(hist + 4 * lane) = (u32x4){0u, 0u, 0u, 0u};
        LDS_WAIT();
#pragma unroll 1
        for (int i0 = 0; i0 < imax4; i0 += 4) {
            f32x4 x[4];
#pragma unroll
            for (int u = 0; u < 4; ++u) x[u] = *(LAS f32x4*)(myp + 256 * (i0 + u));
#pragma unroll
            for (int u = 0; u < 4; ++u)
#pragma unroll
                for (int j = 0; j < 4; ++j) { const int b = sel_bin(x[u][j], lo, scale); const int hb = (x[u][j] > -INFINITY) ? b : 256; __hip_atomic_fetch_add(hist + hb, 1u, __ATOMIC_RELAXED, __HIP_MEMORY_SCOPE_WORKGROUP); } }
        LDS_WAIT();
        const u32x4 h4 = *(const LAS u32x4*)(hist + 4 * lane);
        const unsigned c4 = h4.x + h4.y + h4.z + h4.w;
        unsigned suf = c4;
#pragma unroll
        for (int o = 1; o < 64; o <<= 1) { const unsigned t = __shfl_down(suf, o); suf += (lane + o < 64) ? t : 0u; }
        unsigned run = suf - c4; int fb = -1; unsigned fabove = 0, fm = 0;
        { const unsigned nd = (unsigned)need;
          if (run < nd && run + h4.w >= nd) { fb = 4 * lane + 3; fabove = run; fm = h4.w; } run += h4.w;
          if (run < nd && run + h4.z >= nd) { fb = 4 * lane + 2; fabove = run; fm = h4.z; } run += h4.z;
          if (run < nd && run + h4.y >= nd) { fb = 4 * lane + 1; fabove = run; fm = h4.y; } run += h4.y;
          if (run < nd && run + h4.x >= nd) { fb = 4 * lane + 0; fabove = run; fm = h4.x; } }
        const unsigned long long bal = __ballot(fb >= 0);
        const int src = __ffsll((long long)bal) - 1;
        const int bstar = __shfl(fb, src); const unsigned above = (unsigned)__shfl((int)fabove, src); m = (unsigned)__shfl((int)fm, src);
        unsigned off = (unsigned)base;
        float nmx = -INFINITY, nmn = INFINITY;
#pragma unroll 1
        for (int i0 = 0; i0 < imax4; i0 += 4) {
            f32x4 x[4];
#pragma unroll
            for (int u = 0; u < 4; ++u) x[u] = *(LAS f32x4*)(myp + 256 * (i0 + u));
#pragma unroll
            for (int u = 0; u < 4; ++u) {
#pragma unroll
                for (int j = 0; j < 4; ++j) { const float xv = x[u][j]; const int b = sel_bin(xv, lo, scale); const bool isc = xv > -INFINITY; const bool sel = isc && b > bstar, kp = isc && b == bstar;
                    const unsigned long long sm = __ballot(sel);
                    outl[sel ? off + lane_rank(sm) : 256u] = (bf16_t)(256 * (i0 + u) + 4 * lane + j); off += (unsigned)__popcll(sm);
                    const float y = kp ? xv : -INFINITY; x[u][j] = y; nmx = fmaxf(nmx, y); nmn = fminf(nmn, kp ? y : INFINITY); }
                *(LAS f32x4*)(myp + 256 * (i0 + u)) = x[u]; } }
        base += (int)above; need -= (int)above; lmx = nmx; lmn = nmn;
        if (m <= (unsigned)SEL_CAP) break;
        if (!(wave_max(nmx) > wave_min(nmn))) break;
    }
    {
        unsigned pos = 0u;
#pragma unroll 1
        for (int i0 = 0; i0 < imax4; i0 += 4) {
            f32x4 x[4];
#pragma unroll
            for (int u = 0; u < 4; ++u) x[u] = *(LAS f32x4*)(myp + 256 * (i0 + u));
#pragma unroll
            for (int u = 0; u < 4; ++u)
#pragma unroll
                for (int j = 0; j < 4; ++j) { const bool isc = x[u][j] > -INFINITY; const unsigned long long cmk = __ballot(isc); const unsigned my = pos + lane_rank(cmk);
                    u32x2 c; c.x = __float_as_uint(x[u][j]); c.y = (unsigned)(256 * (i0 + u) + 4 * lane + j);
                    cand[(isc && my < (unsigned)SEL_CAP) ? my : (unsigned)SEL_CAP] = c; pos += (unsigned)__popcll(cmk); } }
    }
    LDS_WAIT();
    if (m <= (unsigned)SEL_CAP) {
        for (unsigned ci = lane; ci < m; ci += 64) {
            const u32x2 my = cand[ci]; const float mv = __uint_as_float(my.x); int rank = 0;
            for (unsigned j = 0; j < m; ++j) { const u32x2 o = cand[j]; const float ov = __uint_as_float(o.x); rank += (ov > mv || (ov == mv && o.y < my.y)) ? 1 : 0; }
            if (rank < need) outl[base + rank] = (bf16_t)my.y;
        }
    } else {
        for (unsigned ci = lane; ci < (unsigned)SEL_CAP; ci += 64) if ((int)ci < need) outl[base + ci] = (bf16_t)cand[ci].y;
    }
    LDS_WAIT();
    *(u32x2*)(out + 4 * lane) = *(const LAS u32x2*)(outl + 4 * lane);
    LDS_WAIT();
}

static_assert(IDX_SEL_OFF + 8 * SEL_WLDS <= LDS_BYTES, "indexer LDS");
__device__ __forceinline__ float dpp_xor8_add(float x) {
    return x + __builtin_bit_cast(float, __builtin_amdgcn_update_dpp(0, __builtin_bit_cast(int, x), 0x128, 0xf, 0xf, true));
}
__device__ __forceinline__ void indexer_prefetch(const Params& p, int b, int p0, int lane, u32x4 (&qraw)[4][2], f32x4 (&cs)[4], float (&wraw)[4]) {
    unsigned char* ws = p.ws;
    const int q = lane & 7, hsel = (lane >> 3) & 1, grp = lane >> 4, tq = b * SEQ + p0 + q;
    const float* csp = (const float*)(ws + WS_ROPE32) + ((size_t)(p0 + q) * 32 + 8 * grp) * 2;
#pragma unroll
    for (int j4 = 0; j4 < 4; ++j4) cs[j4] = *(const f32x4*)(csp + 4 * j4);
#pragma unroll
    for (int hp = 0; hp < 4; ++hp) { const int head = 2 * hp + hsel;
        const bf16_t* src = (const bf16_t*)(ws + WS_QI) + (size_t)tq * 512 + head * 64 + 8 * grp;
        qraw[hp][0] = *(const u32x4*)src; qraw[hp][1] = *(const u32x4*)(src + 32);
        wraw[hp] = bf2f(((const bf16_t*)(ws + WS_KW))[(size_t)tq * 256 + 64 + head]); }
}
template <int MODE> __device__ __forceinline__ void indexer_phase(const Params& p, LAS unsigned char* lds, int bid, int G, int lane, int wave) {
    unsigned char* ws = p.ws;
    LAS float* SC = (LAS float*)lds;
    const int q = lane & 7, grp = lane >> 4, row = lane & 15;
    int pi2 = 2 * bid;
    if (pi2 >= 4096) return;
    u32x4 nqraw[4][2]; f32x4 ncs[4]; float nwraw[4];
    { const int pi = pi2 >> 1; indexer_prefetch(p, pi >> 8, (pi2 & 1) ? 8 * (511 - (pi & 255)) : 8 * (pi & 255), lane, nqraw, ncs, nwraw); }
#pragma unroll 1
    while (pi2 < 4096) {
        const int pi = pi2 >> 1, b = pi >> 8, pr = pi & 255, p0 = (pi2 & 1) ? 8 * (511 - pr) : 8 * pr, tq0 = b * SEQ + p0;
        const int nxt = pi2 + ((pi2 & 1) ? 2 * G - 1 : 1);
        bf16x8 bq[4][2]; float w[4];
        {
            float c[8], s[8];
#pragma unroll
            for (int j4 = 0; j4 < 4; ++j4) { const f32x4 t = ncs[j4]; c[2 * j4] = t.x; s[2 * j4] = t.y; c[2 * j4 + 1] = t.z; s[2 * j4 + 1] = t.w; }
#pragma unroll
            for (int hp = 0; hp < 4; ++hp) { float x0[8], x1[8], o0[8], o1[8]; unpack8(nqraw[hp][0], x0); unpack8(nqraw[hp][1], x1);
#pragma unroll
                for (int j = 0; j < 8; ++j) { o0[j] = (x0[j] * c[j] - x1[j] * s[j]) * 0.125f; o1[j] = (x1[j] * c[j] + x0[j] * s[j]) * 0.125f; }
                bq[hp][0] = pack8(o0); bq[hp][1] = pack8(o1); w[hp] = nwraw[hp] * 0.35355339059327373f; }
        }
        const int nkt = (p0 >> 4) + 1;
        const bf16_t* kbase = (const bf16_t*)(ws + WS_KIN) + (size_t)(b * SEQ) * 64 + grp * 128 + row * 8;
        bf16x8 n0[4], n1[4];
#define IDX_TLOAD(KT0) do { _Pragma("unroll") for (int u = 0; u < 4; ++u) { const int kt = (KT0) + 8 * u < nkt ? (KT0) + 8 * u : wave; const bf16_t* kp = kbase + (size_t)kt * 1024; \
            n0[u] = *(const bf16x8*)kp; n1[u] = *(const bf16x8*)(kp + 512); } } while (0)
        if (MODE != 2 && wave < nkt) IDX_TLOAD(wave);
        for (int kt0 = wave; MODE != 2 && kt0 < nkt; kt0 += 32) {
            bf16x8 a0[4], a1[4];
#pragma unroll
            for (int u = 0; u < 4; ++u) { a0[u] = n0[u]; a1[u] = n1[u]; }
            IDX_TLOAD(kt0 + 32);
#pragma unroll
            for (int u = 0; u < 4; ++u) {
                const int kt = kt0 + 8 * u;
                if (kt >= nkt) break;
                f32x4 acc = (f32x4){0.f, 0.f, 0.f, 0.f};
#pragma unroll
                for (int hp = 0; hp < 4; ++hp) { f32x4 c = (f32x4){0.f, 0.f, 0.f, 0.f}; c = MFMA16(a0[u], bq[hp][0], c); c = MFMA16(a1[u], bq[hp][1], c);
#pragma unroll
                    for (int r = 0; r < 4; ++r) acc[r] += fmaxf(c[r], 0.f) * w[hp]; }
#pragma unroll
                for (int r = 0; r < 4; ++r) { acc[r] = dpp_xor8_add(acc[r]); if (16 * kt + 4 * grp + r > p0 + q) acc[r] = -INFINITY; }
                if (row < 8 && kt < nkt) *(LAS f32x4*)(SC + q * SC_STRIDE + 16 * kt + 4 * grp) = acc;
            }
        }
#undef IDX_TLOAD
        __syncthreads();
        if (nxt < 4096) { const int npi = nxt >> 1; indexer_prefetch(p, npi >> 8, (nxt & 1) ? 8 * (511 - (npi & 255)) : 8 * (npi & 255), lane, nqraw, ncs, nwraw); }
        {
            const int pos = p0 + wave, n = pos + 1;
            bf16_t* out = (bf16_t*)(ws + WS_IDX) + (size_t)(tq0 + wave) * 256;
            if (MODE == 1) { }
            else if (n <= 256) { for (int i = lane; i < 256; i += 64) out[i] = (bf16_t)(i < n ? i : 0); }
            else select_top256(SC + wave * SC_STRIDE, n, out, lds + IDX_SEL_OFF + wave * SEL_WLDS, lane);
        }
        __syncthreads();
        pi2 = nxt;
    }
}

constexpr int ATT_RS = 288;
constexpr int ATT_KOFF = 32 * ATT_RS;
constexpr int ATT_WLDS = 64 * ATT_RS;
typedef short s16x4 __attribute__((ext_vector_type(4)));
__device__ __forceinline__ s16x4 lds_tr16(const LAS unsigned char* pp) { return __builtin_amdgcn_ds_read_tr16_b64_v4i16((LAS s16x4*)pp); }
template <int DRY> __device__ __forceinline__ void attn_item(const Params& p, LAS unsigned char* wlds, int tq, int g, int lane, const unsigned (&idx_in)[4], const u32x4 (&q_in)[4]) {
    unsigned char* ws = p.ws;
    const int b = tq >> 12, pos = tq & (SEQ - 1), cnt = pos + 1 < 256 ? pos + 1 : 256;
    const int row = lane & 15, grp = lane >> 4;
    bf16_t* Qrow = (bf16_t*)(ws + WS_Q) + (size_t)tq * 1024 + g * 512;
    unsigned idxr[4];
#pragma unroll
    for (int r = 0; r < 4; ++r) { idxr[r] = (64 * r + lane < cnt) ? idx_in[r] : 0u; if (DRY) idxr[r] &= (unsigned)(DRY - 1); }
    long qf8[4]; float sfix;
    {
        float qa[16], qb[16]; float ss = 0.f;
        unpack8(q_in[0], qa); unpack8(q_in[1], qa + 8); unpack8(q_in[2], qb); unpack8(q_in[3], qb + 8);
#pragma unroll
        for (int j = 0; j < 16; ++j) ss += qa[j] * qa[j] + qb[j] * qb[j];
        ss += __shfl_xor(ss, 16); ss += __shfl_xor(ss, 32);
        const float rstd = rsqrtf(ss * (1.f / 128.f) + EPS) * 0.08838834764831845f;
        const float* gn = ((const float*)(ws + WS_CONST)) + C_QN + 16 * grp;
        const float* cs = (const float*)(ws + WS_ROPE64) + ((size_t)pos * 64 + 16 * grp) * 2;
        float am = 0.f;
#pragma unroll
        for (int j4 = 0; j4 < 4; ++j4) { const f32x4 ga = *(const f32x4*)(gn + 4 * j4), gb = *(const f32x4*)(gn + 64 + 4 * j4); const f32x4 t0 = *(const f32x4*)(cs + 8 * j4), t1 = *(const f32x4*)(cs + 8 * j4 + 4);
            const float gav[4] = {ga.x, ga.y, ga.z, ga.w}, gbv[4] = {gb.x, gb.y, gb.z, gb.w}, cv[4] = {t0.x, t0.z, t1.x, t1.z}, sv[4] = {t0.y, t0.w, t1.y, t1.w};
#pragma unroll
            for (int u = 0; u < 4; ++u) { const int j = 4 * j4 + u; const float a = qa[j] * rstd * gav[u], bb = qb[j] * rstd * gbv[u];
                qa[j] = a * cv[u] - bb * sv[u]; qb[j] = bb * cv[u] + a * sv[u]; am = fmaxf(am, fmaxf(fabsf(qa[j]), fabsf(qb[j]))); } }
        am = fmaxf(am, __shfl_xor(am, 16)); am = fmaxf(am, __shfl_xor(am, 32));
        const float sc = am > 0.f ? 240.0f / am : 1.0f; sfix = (am > 0.f ? am * (1.0f / 240.0f) : 1.0f) * (1.4426950408889634f / K8_SCALE);
#pragma unroll
        for (int m = 0; m < 4; ++m) { const float* v = (m < 2 ? qa : qb) + 8 * (m & 1); int lo = 0, hi = 0;
            lo = __builtin_amdgcn_cvt_pk_fp8_f32(v[0] * sc, v[1] * sc, lo, false); lo = __builtin_amdgcn_cvt_pk_fp8_f32(v[2] * sc, v[3] * sc, lo, true);
            hi = __builtin_amdgcn_cvt_pk_fp8_f32(v[4] * sc, v[5] * sc, hi, false); hi = __builtin_amdgcn_cvt_pk_fp8_f32(v[6] * sc, v[7] * sc, hi, true);
            qf8[m] = (long)(((unsigned long long)(unsigned)hi << 32) | (unsigned long long)(unsigned)lo); }
    }
    f32x4 S[16];
    {
        const unsigned char* Kb = ws + WS_K8; const unsigned koff = (unsigned)b * (SEQ * 256u) + g * 128u + 16u * (lane & 7);
        LAS unsigned char* kst = wlds + ATT_KOFF + (lane >> 3) * 144 + 16 * (lane & 7);
        const LAS unsigned char* kfr = wlds + ATT_KOFF + row * 144 + 16 * grp;
        u32x4 kr[4][2];
#define ATT_KLOAD(BUF, KT) do { _Pragma("unroll") for (int i = 0; i < 2; ++i) { const int slot = 16 * (KT) + 8 * i; \
            const unsigned e = (unsigned)__shfl((int)idxr[slot >> 6], (slot & 63) + (lane >> 3)); kr[BUF][i] = *(const u32x4*)(Kb + (e * 256u + koff)); } } while (0)
        ATT_KLOAD(0, 0); ATT_KLOAD(1, 1); ATT_KLOAD(2, 2); ATT_KLOAD(3, 3);
#pragma unroll
        for (int kt = 0; kt < 16; ++kt) {
            const int buf = kt & 3;
#pragma unroll
            for (int i = 0; i < 2; ++i) *(LAS u32x4*)(kst + buf * (16 * 144) + 8 * i * 144) = kr[buf][i];
            if (kt + 4 < 16) ATT_KLOAD(buf, kt + 4);
            LDS_WAIT();
            const u32x4 r0 = *(const LAS u32x4*)(kfr + buf * (16 * 144)), r1 = *(const LAS u32x4*)(kfr + buf * (16 * 144) + 64);
            f32x4 acc = (f32x4){0.f, 0.f, 0.f, 0.f};
            acc = __builtin_amdgcn_mfma_f32_16x16x32_fp8_fp8((long)(((unsigned long long)r0.y << 32) | r0.x), qf8[0], acc, 0, 0, 0);
            acc = __builtin_amdgcn_mfma_f32_16x16x32_fp8_fp8((long)(((unsigned long long)r0.w << 32) | r0.z), qf8[1], acc, 0, 0, 0);
            acc = __builtin_amdgcn_mfma_f32_16x16x32_fp8_fp8((long)(((unsigned long long)r1.y << 32) | r1.x), qf8[2], acc, 0, 0, 0);
            acc = __builtin_amdgcn_mfma_f32_16x16x32_fp8_fp8((long)(((unsigned long long)r1.w << 32) | r1.z), qf8[3], acc, 0, 0, 0);
            S[kt] = acc * sfix;
            __builtin_amdgcn_sched_barrier(0);
        }
#undef ATT_KLOAD
    }
    bf16x8 pf[8]; float pinv;
    {
        if (cnt < 256) {
#pragma unroll
            for (int kt = 0; kt < 16; ++kt)
#pragma unroll
                for (int r = 0; r < 4; ++r) if (16 * kt + 4 * grp + r >= cnt) S[kt][r] = -INFINITY;
        }
        float mx = -INFINITY;
#pragma unroll
        for (int kt = 0; kt < 16; ++kt) mx = fmaxf(mx, fmaxf(fmaxf(S[kt][0], S[kt][1]), fmaxf(S[kt][2], S[kt][3])));
        mx = fmaxf(mx, __shfl_xor(mx, 16)); mx = fmaxf(mx, __shfl_xor(mx, 32));
        float sum = 0.f;
#pragma unroll
        for (int kt = 0; kt < 16; ++kt)
#pragma unroll
            for (int r = 0; r < 4; ++r) { const float ev = __builtin_amdgcn_exp2f(S[kt][r] - mx); S[kt][r] = ev; sum += ev; }
        sum += __shfl_xor(sum, 16); sum += __shfl_xor(sum, 32);
        pinv = frcp(sum);
#pragma unroll
        for (int ks = 0; ks < 8; ++ks) { float t[8];
#pragma unroll
            for (int r = 0; r < 4; ++r) { t[r] = S[2 * ks][r]; t[4 + r] = S[2 * ks + 1][r]; }
            pf[ks] = pack8(t); }
    }
    f32x4 O[8];
#pragma unroll
    for (int mt = 0; mt < 8; ++mt) O[mt] = (f32x4){0.f, 0.f, 0.f, 0.f};
    const unsigned char* Vb = ws + WS_V; const unsigned voff = (unsigned)b * (SEQ * 512u) + g * 256u + 16u * row;
    LAS unsigned char* wst = wlds + grp * ATT_RS + 16 * row;
    const LAS unsigned char* trp = wlds + (4 * grp + (row >> 2)) * ATT_RS + 8 * (row & 3);
    u32x4 vr[8];
#define ATT_VLOAD(RD) do { _Pragma("unroll") for (int i = 0; i < 8; ++i) { const int slot = 32 * (RD) + 4 * i; \
        const unsigned e = (unsigned)__shfl((int)idxr[slot >> 6], (slot & 63) + grp); vr[i] = *(const u32x4*)(Vb + (e * 512u + voff)); } } while (0)
    __builtin_amdgcn_sched_barrier(0);
    ATT_VLOAD(0);
#pragma unroll
    for (int rd = 0; rd < 8; ++rd) {
#pragma unroll
        for (int i = 0; i < 8; ++i) *(LAS u32x4*)(wst + 4 * i * ATT_RS) = vr[i];
        if (rd < 7) ATT_VLOAD(rd + 1);
        LDS_WAIT();
#pragma unroll
        for (int mt = 0; mt < 8; ++mt) {
            const s16x4 t0 = lds_tr16(trp + 32 * mt), t1 = lds_tr16(trp + 16 * ATT_RS + 32 * mt);
            const bf16x8 a = (bf16x8){t0[0], t0[1], t0[2], t0[3], t1[0], t1[1], t1[2], t1[3]};
            O[mt] = MFMA16(a, pf[rd], O[mt]);
        }
        LDS_WAIT();
    }
#undef ATT_VLOAD
    if (row < 4 && (!DRY || O[0][0] == 12345.678f)) {
        bf16_t* op = Qrow + row * 128 + 4 * grp;
#pragma unroll
        for (int mt = 0; mt < 8; ++mt) { u32x2 w; w.x = pk2(O[mt][0] * pinv, O[mt][1] * pinv); w.y = pk2(O[mt][2] * pinv, O[mt][3] * pinv); *(u32x2*)(op + 16 * mt) = w; }
    }
}
__device__ __forceinline__ void attn_prefetch(const Params& p, int tq, int g, int lane, unsigned (&idx_o)[4], u32x4 (&q_o)[4]) {
    const bf16_t* ip = (const bf16_t*)(p.ws + WS_IDX) + (size_t)tq * 256;
#pragma unroll
    for (int r = 0; r < 4; ++r) idx_o[r] = (unsigned)ip[64 * r + lane];
    const int row = lane & 15, grp = lane >> 4;
    const bf16_t* qp = (const bf16_t*)(p.ws + WS_Q) + (size_t)tq * 1024 + g * 512 + (row & 3) * 128 + 16 * grp;
    const u32x4 z = (u32x4){0u, 0u, 0u, 0u};
    const u32x4 a = *(const u32x4*)qp, b2 = *(const u32x4*)(qp + 8), c = *(const u32x4*)(qp + 64), d = *(const u32x4*)(qp + 72);
    q_o[0] = row < 4 ? a : z; q_o[1] = row < 4 ? b2 : z; q_o[2] = row < 4 ? c : z; q_o[3] = row < 4 ? d : z;
}
template <int DRY> __device__ __forceinline__ void attn_phase(const Params& p, LAS unsigned char* wlds, int nc, int cls, int cw, int ncw, int lane) {
    const int nbat = (NBATCH - cls + nc - 1) / nc, total = nbat * 2 * SEQ;
    if (cw >= total) return;
    unsigned nidx[4]; u32x4 nq[4];
    { const int f = cw; attn_prefetch(p, (cls + nc * (f >> 13)) * SEQ + (f & (SEQ - 1)), (f >> 12) & 1, lane, nidx, nq); }
    for (int f = cw; f < total; f += ncw) {
        unsigned cidx[4]; u32x4 cq[4];
#pragma unroll
        for (int r = 0; r < 4; ++r) { cidx[r] = nidx[r]; cq[r] = nq[r]; }
        const int fn = f + ncw < total ? f + ncw : f;
        attn_prefetch(p, (cls + nc * (fn >> 13)) * SEQ + (fn & (SEQ - 1)), (fn >> 12) & 1, lane, nidx, nq);
        attn_item<DRY>(p, wlds, (cls + nc * (f >> 13)) * SEQ + (f & (SEQ - 1)), (f >> 12) & 1, lane, cidx, cq);
    }
}

constexpr int MEM_CS = 528;
constexpr int MEM_CHUNK = 32 * MEM_CS;
constexpr int MEM_POFF = 2 * MEM_CHUNK;
constexpr int MEM_PW = 16 * 528;
static_assert(MEM_POFF + 8 * MEM_PW <= LDS_BYTES, "memattn LDS");
__device__ __forceinline__ void memattn_block(const Params& p, LAS unsigned char* lds, int item, int lane, int wave) {
    unsigned char* ws = p.ws;
    const int tile = item >> 2, hm = item & 3, t0 = tile * 128 + wave * 16, b = (tile * 128) >> 12;
    const int row = lane & 15, grp = lane >> 4;
    bf16_t* MQ = (bf16_t*)(ws + WS_MQ);
    bf16x8 af[8];
    {
        float ss = 0.f;
        const bf16_t* src = MQ + (size_t)(t0 + row) * 1024 + hm * 256 + 8 * grp;
#pragma unroll
        for (int ks = 0; ks < 8; ++ks) { float qv[8]; unpack8(*(const u32x4*)(src + 32 * ks), qv);
#pragma unroll
            for (int j = 0; j < 8; ++j) ss += qv[j] * qv[j]; }
        ss += __shfl_xor(ss, 16); ss += __shfl_xor(ss, 32);
        const float rstd = rsqrtf(ss * (1.f / 256.f) + EPS) * 0.0625f;
        __builtin_amdgcn_sched_barrier(0);
#pragma unroll
        for (int ks = 0; ks < 8; ++ks) { float qv[8]; unpack8(*(const u32x4*)(src + 32 * ks), qv);
            const f32x4 g0 = *(const f32x4*)(((const float*)(ws + WS_CONST)) + C_MQN + 32 * ks + 8 * grp), g1 = *(const f32x4*)(((const float*)(ws + WS_CONST)) + C_MQN + 32 * ks + 8 * grp + 4);
            qv[0] *= rstd * g0.x; qv[1] *= rstd * g0.y; qv[2] *= rstd * g0.z; qv[3] *= rstd * g0.w;
            qv[4] *= rstd * g1.x; qv[5] *= rstd * g1.y; qv[6] *= rstd * g1.z; qv[7] *= rstd * g1.w;
            af[ks] = pack8(qv);
            if (ks & 1) __builtin_amdgcn_sched_barrier(0); }
    }
    const int tid = wave * 64 + lane;
    const unsigned char* MKg = ws + WS_MKN; const unsigned mkoff = ((unsigned)(b * 256) * 1024u + hm * 256u) * 2u;
    const unsigned char* MVg = ws + WS_MVT; const unsigned mvoff = (unsigned)(b * 4 + hm) * 131072u;
    const int cr0 = tid >> 5, cc = tid & 31;
    LAS unsigned char* cst = lds + cr0 * MEM_CS + 16 * cc;
    const LAS unsigned char* cfr = lds + row * MEM_CS + 16 * grp;
    u32x4 cg[2];
#define MEM_CLOAD(C) do { if ((C) < 8) { _Pragma("unroll") for (int j = 0; j < 2; ++j) cg[j] = *(const u32x4*)(MKg + (mkoff + (unsigned)(32 * (C) + cr0 + 16 * j) * 2048u + 16u * cc)); } \
        else { _Pragma("unroll") for (int j = 0; j < 2; ++j) cg[j] = *(const u32x4*)(MVg + (mvoff + (unsigned)(32 * ((C) - 8) + cr0 + 16 * j) * 512u + 16u * cc)); } } while (0)
#define MEM_CSTORE(BUF) do { _Pragma("unroll") for (int j = 0; j < 2; ++j) *(LAS u32x4*)(cst + (BUF) * MEM_CHUNK + 16 * j * MEM_CS) = cg[j]; } while (0)
    MEM_CLOAD(0); MEM_CSTORE(0);
    __syncthreads();
    f32x4 S[16];
#pragma unroll
    for (int c = 0; c < 8; ++c) {
        MEM_CLOAD(c + 1);
#pragma unroll
        for (int n2 = 0; n2 < 2; ++n2) { f32x4 acc = (f32x4){0.f, 0.f, 0.f, 0.f};
#pragma unroll
            for (int ks = 0; ks < 8; ++ks) acc = MFMA16(af[ks], *(const LAS bf16x8*)(cfr + (c & 1) * MEM_CHUNK + 16 * n2 * MEM_CS + 64 * ks), acc);
            S[2 * c + n2] = acc; }
        MEM_CSTORE((c + 1) & 1);
        __syncthreads();
    }
#pragma unroll
    for (int r = 0; r < 4; ++r) {
        float mx = -INFINITY;
#pragma unroll
        for (int nt = 0; nt < 16; ++nt) mx = fmaxf(mx, S[nt][r]);
#pragma unroll
        for (int o = 1; o < 16; o <<= 1) mx = fmaxf(mx, __shfl_xor(mx, o));
        float sum = 0.f;
#pragma unroll
        for (int nt = 0; nt < 16; ++nt) { const float e = __expf(S[nt][r] - mx); S[nt][r] = e; sum += e; }
#pragma unroll
        for (int o = 1; o < 16; o <<= 1) sum += __shfl_xor(sum, o);
        const float inv = frcp(sum);
#pragma unroll
        for (int nt = 0; nt < 16; ++nt) S[nt][r] *= inv;
    }
    LAS unsigned char* pw = lds + MEM_POFF + wave * MEM_PW;
#pragma unroll
    for (int nt = 0; nt < 16; ++nt)
#pragma unroll
        for (int r = 0; r < 4; ++r) *(LAS bf16_t*)(pw + (4 * grp + r) * 528 + (16 * nt + row) * 2) = (bf16_t)f2bf(S[nt][r]);
    LDS_WAIT();
    bf16x8 pf[8];
#pragma unroll
    for (int ks = 0; ks < 8; ++ks) pf[ks] = *(const LAS bf16x8*)(pw + row * 528 + (32 * ks + 8 * grp) * 2);
    const unsigned ooff = (unsigned)(t0 + 4 * grp) * 1024u + hm * 256u + row;
#pragma unroll
    for (int c = 8; c < 16; ++c) {
        if (c + 1 < 16) MEM_CLOAD(c + 1);
#pragma unroll
        for (int n2 = 0; n2 < 2; ++n2) { f32x4 acc = (f32x4){0.f, 0.f, 0.f, 0.f};
#pragma unroll
            for (int ks = 0; ks < 8; ++ks) acc = MFMA16(pf[ks], *(const LAS bf16x8*)(cfr + (c & 1) * MEM_CHUNK + 16 * n2 * MEM_CS + 64 * ks), acc);
#pragma unroll
            for (int r = 0; r < 4; ++r) MQ[ooff + (unsigned)(r * 1024 + 16 * (2 * (c - 8) + n2))] = (bf16_t)f2bf(acc[r]); }
        if (c + 1 < 16) MEM_CSTORE((c + 1) & 1);
        __syncthreads();
    }
#undef MEM_CLOAD
#undef MEM_CSTORE
}

#define CE_DESC(a, b) do { const unsigned _mx = (a) > (b) ? (a) : (b); const unsigned _mn = (a) > (b) ? (b) : (a); (a) = _mx; (b) = _mn; } while (0)
__device__ __forceinline__ void sort16_desc(unsigned (&a)[16]) {
#pragma unroll
    for (int k = 2; k <= 16; k <<= 1)
#pragma unroll
        for (int j = k >> 1; j > 0; j >>= 1)
#pragma unroll
            for (int i = 0; i < 16; ++i) { const int l = i ^ j; if (l > i) { if ((i & k) == 0) CE_DESC(a[i], a[l]); else CE_DESC(a[l], a[i]); } }
}
__device__ __forceinline__ void merge_top16(unsigned (&a)[16], const unsigned (&b)[16]) {
#pragma unroll
    for (int i = 0; i < 16; ++i) a[i] = a[i] > b[15 - i] ? a[i] : b[15 - i];
#pragma unroll
    for (int j = 8; j > 0; j >>= 1)
#pragma unroll
        for (int i = 0; i < 16; ++i) { const int l = i ^ j; if (l > i) CE_DESC(a[i], a[l]); }
}
__device__ __forceinline__ unsigned f2sortable(float f) { const unsigned u = __float_as_uint(f); return u ^ (((unsigned)((int)u >> 31)) | 0x80000000u); }
__device__ __forceinline__ float sortable2f(unsigned s) { const unsigned u = (s & 0x80000000u) ? (s ^ 0x80000000u) : ~s; return __uint_as_float(u); }

constexpr int PEER_WLDS = 64 * 32;
constexpr int PR_RS = 288, PR_SK_BYTES = 256 * PR_RS;
__device__ __forceinline__ void peer_route_item(const Params& p, const LAS unsigned char* skl, LAS unsigned char* wlds, int tt, int h, int lane) {
    unsigned char* ws = p.ws;
    const int t0 = tt * 16;
    const int row = lane & 15, grp = lane >> 4;
    unsigned top[2][16];
#pragma unroll
    for (int ph = 0; ph < 2; ++ph) {
        const int hp = h * 2 + ph;
        bf16x8 bf[4];
        { const bf16_t* qp = (const bf16_t*)(ws + WS_PQ) + (size_t)(t0 + row) * 2048 + hp * 128 + 8 * grp;
#pragma unroll
          for (int ks = 0; ks < 4; ++ks) bf[ks] = *(const bf16x8*)(qp + 32 * ks); }
        const LAS unsigned char* sk = skl + ph * (128 * PR_RS) + row * PR_RS + 16 * grp;
        unsigned keys[32];
#pragma unroll
        for (int mt = 0; mt < 8; ++mt) { f32x4 acc = (f32x4){0.f, 0.f, 0.f, 0.f}; const LAS unsigned char* ap = sk + 16 * mt * PR_RS;
#pragma unroll
            for (int ks = 0; ks < 4; ++ks) acc = MFMA16(*(const LAS bf16x8*)(ap + 64 * ks), bf[ks], acc);
#pragma unroll
            for (int r = 0; r < 4; ++r) { const int key = 16 * mt + 4 * grp + r; keys[4 * mt + r] = (f2sortable(acc[r]) & 0xFFFFFF80u) | (unsigned)(127 - key); } }
        unsigned a[16], bb[16];
#pragma unroll
        for (int i = 0; i < 16; ++i) { a[i] = keys[i]; bb[i] = keys[16 + i]; }
        sort16_desc(a); sort16_desc(bb); merge_top16(a, bb);
#pragma unroll
        for (int i = 0; i < 16; ++i) bb[i] = (unsigned)__shfl_xor((int)a[i], 16);
        merge_top16(a, bb);
#pragma unroll
        for (int i = 0; i < 16; ++i) bb[i] = (unsigned)__shfl_xor((int)a[i], 32);
        merge_top16(a, bb);
#pragma unroll
        for (int i = 0; i < 16; ++i) top[ph][i] = a[i];
    }
    LAS unsigned* myb = (LAS unsigned*)(wlds + lane * 32);
#pragma unroll
    for (int ph = 0; ph < 2; ++ph)
#pragma unroll
        for (int w4 = 0; w4 < 4; ++w4) { unsigned pk = 0u;
#pragma unroll
            for (int j = 0; j < 4; ++j) pk |= (127u - (top[ph][4 * w4 + j] & 0x7Fu)) << (8 * j);
            myb[ph * 4 + w4] = pk; }
    float v1[16], v2[16];
#pragma unroll
    for (int i = 0; i < 16; ++i) { v1[i] = sortable2f(top[0][i] & 0xFFFFFF80u); v2[i] = sortable2f(top[1][i] & 0xFFFFFF80u); }
    unsigned c[4][16];
    {
        int ci = 0;
#pragma unroll
        for (int r1 = 0; r1 < 16; ++r1)
#pragma unroll
            for (int r2 = 0; r2 < 16; ++r2) if ((r1 + 1) * (r2 + 1) <= 16) { c[ci >> 4][ci & 15] = (f2sortable(v1[r1] + v2[r2]) & 0xFFFFFF00u) | (unsigned)(255 - (r1 * 16 + r2)); ++ci; }
#pragma unroll
        for (int z = 50; z < 64; ++z) c[z >> 4][z & 15] = 0u;
    }
    sort16_desc(c[0]); sort16_desc(c[1]); sort16_desc(c[2]); sort16_desc(c[3]);
    merge_top16(c[0], c[1]); merge_top16(c[2], c[3]); merge_top16(c[0], c[2]);
    float gsc[16]; float sum = 0.f; const float vmax = sortable2f(c[0][0] & 0xFFFFFF00u);
#pragma unroll
    for (int i = 0; i < 16; ++i) { gsc[i] = __expf(sortable2f(c[0][i] & 0xFFFFFF00u) - vmax); sum += gsc[i]; }
    const float inv = 1.0f / sum;
    LDS_WAIT();
    int eid[16];
    const LAS unsigned char* mybb = (const LAS unsigned char*)(wlds + lane * 32);
#pragma unroll
    for (int i = 0; i < 16; ++i) { const unsigned flat = 255u - (c[0][i] & 0xFFu); const int i1 = mybb[flat >> 4], i2 = mybb[16 + (flat & 15u)]; eid[i] = i1 * 128 + i2; gsc[i] *= inv; }
    int* eo = (int*)(ws + WS_EIDX) + (size_t)(t0 + row) * 128 + h * 16; float* go = (float*)(ws + WS_EG) + (size_t)(t0 + row) * 128 + h * 16;
    typedef int i32x4 __attribute__((ext_vector_type(4)));
    if (grp == 0) { *(i32x4*)(eo + 0) = (i32x4){eid[0], eid[1], eid[2], eid[3]}; *(f32x4*)(go + 0) = (f32x4){gsc[0], gsc[1], gsc[2], gsc[3]}; }
    else if (grp == 1) { *(i32x4*)(eo + 4) = (i32x4){eid[4], eid[5], eid[6], eid[7]}; *(f32x4*)(go + 4) = (f32x4){gsc[4], gsc[5], gsc[6], gsc[7]}; }
    else if (grp == 2) { *(i32x4*)(eo + 8) = (i32x4){eid[8], eid[9], eid[10], eid[11]}; *(f32x4*)(go + 8) = (f32x4){gsc[8], gsc[9], gsc[10], gsc[11]}; }
    else { *(i32x4*)(eo + 12) = (i32x4){eid[12], eid[13], eid[14], eid[15]}; *(f32x4*)(go + 12) = (f32x4){gsc[12], gsc[13], gsc[14], gsc[15]}; }
    LDS_WAIT();
}

__device__ __forceinline__ void peer_route_phase(const Params& p, LAS unsigned char* lds, int bid, int G, int wave, int lane) {
    const bool split = (G & 7) == 0;
    const int hstart = split ? (bid & 7) : 0, hstep = split ? 8 : 1, trank = split ? (bid >> 3) : bid, tstride = split ? (G >> 3) : G;
    const int tid = wave * 64 + lane;
    for (int h = hstart; h < 8; h += hstep) {
        __syncthreads();
        const unsigned char* src = p.ws + WS_SUBK + (size_t)h * 65536;
#pragma unroll
        for (int j = 0; j < 8; ++j) { const int q = tid + 512 * j, r = q >> 4, c = q & 15; *(LAS u32x4*)(lds + r * PR_RS + 16 * c) = *(const u32x4*)(src + (size_t)r * 256 + 16 * c); }
        __syncthreads();
        for (int tt = trank * NWAVES + wave; tt < T_TOK / 16; tt += tstride * NWAVES) peer_route_item(p, lds, lds + PR_SK_BYTES + wave * PEER_WLDS, tt, h, lane);
    }
}

__device__ __forceinline__ void quant_row_fp8(const float* src, unsigned char* dst, float* inv, int lane) {
    const f32x4* s4 = (const f32x4*)src + 4 * lane;
    f32x4 v[4]; float am = 0.f;
#pragma unroll
    for (int j = 0; j < 4; ++j) { v[j] = s4[j]; am = fmaxf(am, fmaxf(fmaxf(fabsf(v[j].x), fabsf(v[j].y)), fmaxf(fabsf(v[j].z), fabsf(v[j].w)))); }
    am = wave_max(am);
    const float sc = am > 0.f ? 240.0f / am : 1.0f;
    u32x4 o;
#pragma unroll
    for (int j = 0; j < 4; ++j) { int w = 0; w = __builtin_amdgcn_cvt_pk_fp8_f32(v[j].x * sc, v[j].y * sc, w, false); w = __builtin_amdgcn_cvt_pk_fp8_f32(v[j].z * sc, v[j].w * sc, w, true); o[j] = (unsigned)w; }
    *(u32x4*)(dst + (size_t)(lane >> 3) * 2097152 + 16 * (lane & 7)) = o;
    if (lane == 0) *inv = am > 0.f ? am / 240.0f : 1.0f;
}
__device__ __forceinline__ void fp8x4_to_bf16x4(unsigned w, unsigned& lo, unsigned& hi) {
    const f32x2 a = __builtin_amdgcn_cvt_pk_f32_fp8((int)w, false), b = __builtin_amdgcn_cvt_pk_f32_fp8((int)w, true);
    lo = (__float_as_uint(a.x) >> 16) | (__float_as_uint(a.y) & 0xffff0000u);
    hi = (__float_as_uint(b.x) >> 16) | (__float_as_uint(b.y) & 0xffff0000u);
}
constexpr size_t WS_U8 = WS_UB, WS_V8 = WS_UB + 16 * MiB, WS_UVINV = WS_UB + 32 * MiB;
constexpr size_t WS_ZP = WS_PQ;
constexpr size_t WS_ACT = WS_KR;
constexpr int PZ_RS = 144, PZ_LIST = 128 * PZ_RS, PZ_WLDS = PZ_LIST + 1024;
template <int EMASK> __device__ __forceinline__ void peer_zpart_class(const Params& p, LAS unsigned char* wlds, int x, int cw, int ncw, int lane) {
    unsigned char* ws = p.ws;
    const int row = lane & 15, grp = lane >> 4, q = lane >> 3;
    const int* EI = (const int*)(ws + WS_EIDX);
    const unsigned char* U8 = ws + WS_U8; const unsigned uoff = 2097152u * x + 16u * (lane & 7);
    const bf16_t* XNb = (const bf16_t*)(ws + WS_XN) + 128 * x + 16 * grp;
    bf16_t* ZPb = (bf16_t*)(ws + WS_ZP) + (size_t)x * T_TOK * 128 + 4 * grp;
    if (cw >= T_TOK) return;
    typedef int i32x4 __attribute__((ext_vector_type(4)));
    LAS unsigned char* wst = wlds + (16 * q) * PZ_RS + 16 * (lane & 7);
    const LAS unsigned char* frd = wlds + row * PZ_RS + 16 * grp;
    int en[2]; u32x4 raw[16]; bf16x8 xb[4], xn[4];
#define PZ_GATHER(EV, LB) do { LAS int* lst = (LAS int*)(wlds + PZ_LIST + 512 * (LB)); lst[lane] = (EV)[0]; lst[64 + lane] = (EV)[1]; LDS_WAIT(); \
        _Pragma("unroll") for (int i4 = 0; i4 < 4; ++i4) { const i32x4 ev = *(const LAS i32x4*)(lst + 16 * q + 4 * i4); \
            raw[4 * i4 + 0] = *(const u32x4*)(U8 + ((unsigned)(ev.x & EMASK) * 128u + uoff)); raw[4 * i4 + 1] = *(const u32x4*)(U8 + ((unsigned)(ev.y & EMASK) * 128u + uoff)); \
            raw[4 * i4 + 2] = *(const u32x4*)(U8 + ((unsigned)(ev.z & EMASK) * 128u + uoff)); raw[4 * i4 + 3] = *(const u32x4*)(U8 + ((unsigned)(ev.w & EMASK) * 128u + uoff)); } } while (0)
    { const unsigned o = (unsigned)cw * 128u + lane; en[0] = EI[o]; en[1] = EI[o + 64u];
      const bf16_t* XN = XNb + (size_t)cw * 1024; xn[0] = *(const bf16x8*)XN; xn[1] = *(const bf16x8*)(XN + 8); xn[2] = *(const bf16x8*)(XN + 64); xn[3] = *(const bf16x8*)(XN + 72); }
    PZ_GATHER(en, 0);
    { const int t1 = cw + ncw < T_TOK ? cw + ncw : cw; const unsigned o1 = (unsigned)t1 * 128u + lane; en[0] = EI[o1]; en[1] = EI[o1 + 64u]; }
    int lb = 1;
    for (int t = cw; t < T_TOK; t += ncw) {
        bf16_t* zp = ZPb + (size_t)t * 128;
#pragma unroll
        for (int i = 0; i < 16; ++i) *(LAS u32x4*)(wst + i * PZ_RS) = raw[i];
#pragma unroll
        for (int i = 0; i < 4; ++i) xb[i] = xn[i];
        PZ_GATHER(en, lb);
        lb ^= 1;
        { const int t2 = t + 2 * ncw < T_TOK ? t + 2 * ncw : cw; const unsigned o2 = (unsigned)t2 * 128u + lane; en[0] = EI[o2]; en[1] = EI[o2 + 64u];
          const int t1 = t + ncw < T_TOK ? t + ncw : cw; const bf16_t* XN = XNb + (size_t)t1 * 1024; xn[0] = *(const bf16x8*)XN; xn[1] = *(const bf16x8*)(XN + 8); xn[2] = *(const bf16x8*)(XN + 64); xn[3] = *(const bf16x8*)(XN + 72); }
        long xq[4]; float xinv;
        {
            float xf[4][8]; float am = 0.f;
#pragma unroll
            for (int i = 0; i < 4; ++i) { unpack8(__builtin_bit_cast(u32x4, xb[i]), xf[i]);
#pragma unroll
                for (int j = 0; j < 8; ++j) am = fmaxf(am, fabsf(xf[i][j])); }
            am = fmaxf(am, __shfl_xor(am, 16)); am = fmaxf(am, __shfl_xor(am, 32));
            const float sc = am > 0.f ? 240.0f / am : 1.0f; xinv = am > 0.f ? am * (1.0f / 240.0f) : 1.0f;
#pragma unroll
            for (int i = 0; i < 4; ++i) { int lo = 0, hi = 0;
                lo = __builtin_amdgcn_cvt_pk_fp8_f32(xf[i][0] * sc, xf[i][1] * sc, lo, false); lo = __builtin_amdgcn_cvt_pk_fp8_f32(xf[i][2] * sc, xf[i][3] * sc, lo, true);
                hi = __builtin_amdgcn_cvt_pk_fp8_f32(xf[i][4] * sc, xf[i][5] * sc, hi, false); hi = __builtin_amdgcn_cvt_pk_fp8_f32(xf[i][6] * sc, xf[i][7] * sc, hi, true);
                xq[i] = (long)(((unsigned long long)(unsigned)hi << 32) | (unsigned long long)(unsigned)lo); }
        }
#pragma unroll
        for (int et = 0; et < 8; ++et) {
            const u32x4 r0 = *(const LAS u32x4*)(frd + 16 * et * PZ_RS), r1 = *(const LAS u32x4*)(frd + 16 * et * PZ_RS + 64);
            const long a0 = (long)(((unsigned long long)r0.y << 32) | r0.x), a1 = (long)(((unsigned long long)r0.w << 32) | r0.z);
            const long a2 = (long)(((unsigned long long)r1.y << 32) | r1.x), a3 = (long)(((unsigned long long)r1.w << 32) | r1.z);
            f32x4 acc = (f32x4){0.f, 0.f, 0.f, 0.f};
            acc = __builtin_amdgcn_mfma_f32_16x16x32_fp8_fp8(a0, xq[0], acc, 0, 0, 0); acc = __builtin_amdgcn_mfma_f32_16x16x32_fp8_fp8(a1, xq[1], acc, 0, 0, 0);
            acc = __builtin_amdgcn_mfma_f32_16x16x32_fp8_fp8(a2, xq[2], acc, 0, 0, 0); acc = __builtin_amdgcn_mfma_f32_16x16x32_fp8_fp8(a3, xq[3], acc, 0, 0, 0);
            if (row == 0) { u32x2 w; w.x = pk2(acc[0] * xinv, acc[1] * xinv); w.y = pk2(acc[2] * xinv, acc[3] * xinv); *(u32x2*)(zp + 16 * et) = w; }
        }
        LDS_WAIT();
    }
#undef PZ_GATHER
}
__device__ __forceinline__ void peer_act_token(const Params& p, int t, int lane) {
    unsigned char* ws = p.ws;
    const bf16_t* zp = (const bf16_t*)(ws + WS_ZP) + (size_t)t * 128;
    const int* eidp = (const int*)(ws + WS_EIDX) + (size_t)t * 128; const float* egp = (const float*)(ws + WS_EG) + (size_t)t * 128;
    const f32x2* UVINV = (const f32x2*)(ws + WS_UVINV);
    float* ap = (float*)(ws + WS_ACT) + (size_t)t * 128;
#pragma unroll
    for (int r = 0; r < 2; ++r) { const int s = 64 * r + lane; float z = 0.f;
#pragma unroll
        for (int x = 0; x < 8; ++x) z += bf2f(zp[(size_t)x * T_TOK * 128 + s]);
        const f32x2 iv = UVINV[eidp[s]];
        ap[s] = gelu_tanh(z * iv.x) * egp[s] * iv.y; }
}
constexpr int PO_WLDS = 1024 + 4096;
__device__ __forceinline__ void peer_out_class(const Params& p, LAS unsigned char* wlds, int x, int cw, int ncw, int lane) {
    unsigned char* ws = p.ws;
    const int* EI = (const int*)(ws + WS_EIDX); const float* AC = (const float*)(ws + WS_ACT);
    const unsigned char* V8 = ws + WS_V8; const unsigned voff = 2097152u * x + 16u * (lane & 7);
    if (cw >= T_TOK) return;
    typedef int i32x4 __attribute__((ext_vector_type(4)));
    LAS int* lei = (LAS int*)wlds; LAS float* lac = (LAS float*)(wlds + 512); LAS float* lps = (LAS float*)(wlds + 1024);
    const int q = lane >> 3, c = lane & 7;
    int en[2]; float an[2];
    { const unsigned o0 = (unsigned)cw * 128u + lane; en[0] = EI[o0]; en[1] = EI[o0 + 64u]; an[0] = AC[o0]; an[1] = AC[o0 + 64u]; }
    for (int t = cw; t < T_TOK; t += ncw) {
        lei[lane] = en[0]; lei[64 + lane] = en[1]; lac[lane] = an[0]; lac[64 + lane] = an[1];
        { const int t1 = t + ncw < T_TOK ? t + ncw : cw; const unsigned o1 = (unsigned)t1 * 128u + lane; en[0] = EI[o1]; en[1] = EI[o1 + 64u]; an[0] = AC[o1]; an[1] = AC[o1 + 64u]; }
        LDS_WAIT();
        int es[16]; float as[16];
#pragma unroll
        for (int i4 = 0; i4 < 4; ++i4) { const i32x4 ev = *(const LAS i32x4*)(lei + 16 * q + 4 * i4); const f32x4 av = *(const LAS f32x4*)(lac + 16 * q + 4 * i4);
            es[4 * i4] = ev.x; es[4 * i4 + 1] = ev.y; es[4 * i4 + 2] = ev.z; es[4 * i4 + 3] = ev.w; as[4 * i4] = av.x; as[4 * i4 + 1] = av.y; as[4 * i4 + 2] = av.z; as[4 * i4 + 3] = av.w; }
        u32x4 raw[16];
#pragma unroll
        for (int i = 0; i < 16; ++i) raw[i] = *(const u32x4*)(V8 + ((unsigned)es[i] * 128u + voff));
        float o[16];
#pragma unroll
        for (int j = 0; j < 16; ++j) o[j] = 0.f;
#pragma unroll
        for (int i = 0; i < 16; ++i) {
            const float av = as[i]; const u32x4 rw = raw[i];
#pragma unroll
            for (int w = 0; w < 4; ++w) { const f32x2 c0 = __builtin_amdgcn_cvt_pk_f32_fp8((int)rw[w], false), c1 = __builtin_amdgcn_cvt_pk_f32_fp8((int)rw[w], true);
                o[4 * w] += av * c0.x; o[4 * w + 1] += av * c0.y; o[4 * w + 2] += av * c1.x; o[4 * w + 3] += av * c1.y; }
            if (i & 1) __builtin_amdgcn_sched_barrier(0);
        }
#pragma unroll
        for (int w = 0; w < 4; ++w) *(LAS f32x4*)(lps + q * 128 + 16 * c + 4 * w) = (f32x4){o[4 * w], o[4 * w + 1], o[4 * w + 2], o[4 * w + 3]};
        LDS_WAIT();
        f32x2 s = *(const LAS f32x2*)(lps + 2 * lane);
#pragma unroll
        for (int k = 1; k < 8; ++k) { const f32x2 v = *(const LAS f32x2*)(lps + k * 128 + 2 * lane); s.x += v.x; s.y += v.y; }
        float* orow = p.out + (size_t)t * 1024 + 128 * x + 2 * lane;
        f32x2 xv = *(const f32x2*)orow; xv.x += s.x; xv.y += s.y; *(f32x2*)orow = xv;
        LDS_WAIT();
    }
}
#ifndef NOISEQ
#define NOISEQ 0
#endif

#ifndef STAGE
#define STAGE 99
#endif
template <int LAST, int SUB = 9> __global__ void __launch_bounds__(NTHREADS, 2) fwd_megakernel(Params p) {
    extern __shared__ __attribute__((aligned(16))) unsigned char lds_raw[];
    LAS unsigned char* lds = (LAS unsigned char*)lds_raw;
    const int wave = __builtin_amdgcn_readfirstlane((int)threadIdx.x >> 6); int lane = fresh_lane();
    const int G = gridDim.x, bid = blockIdx.x;
    const int gw = bid * NWAVES + wave, NGW = G * NWAVES;
    unsigned char* ws = p.ws;
    if (wave == 0 && lane < 4) ((LAS unsigned*)(lds + LDS_XB_OFF))[lane] = 0u;
    __syncthreads();
    const XcdBarrier xbar = xcd_barrier_post((unsigned*)(ws + WS_CTL), (volatile LAS unsigned*)(lds + LDS_XB_OFF), wave);
    if (wave == 0 && lane == 0) ((LAS unsigned*)(lds + LDS_XB_OFF))[2] = xb_add((unsigned*)(ws + WS_CTL) + 3584 + 64 * xbar.x, 1u);
#define GRID_SYNC() do { xcd_barrier(xbar, wave); lane = fresh_lane(); } while (0)

  {
    constexpr int last = LAST;
    phase_prologue(p, lds, lane, wave, gw, NGW);
    GRID_SYNC();
    int ncls, cls, crank, csize;
    {
        bool bal = (G & 7) == 0; int npop = 0, myidx = 0;
        for (int j = 0; j < 16; ++j) { const unsigned c = xb_ld((unsigned*)(ws + WS_CTL) + XB_XCNT(j)); bal = bal && (c == 0u || c == (unsigned)(G >> 3)); npop += c > 0u ? 1 : 0; myidx += (c > 0u && j < (int)xbar.x) ? 1 : 0; }
        bal = bal && npop == 8;
        const unsigned myrank = ((volatile LAS unsigned*)(lds + LDS_XB_OFF))[2];
        if (bal) { ncls = 8; cls = myidx; crank = (int)myrank; csize = G >> 3; }
        else { ncls = (G & 7) == 0 ? 8 : 1; cls = bid % ncls; crank = bid / ncls; csize = G / ncls; }
        ncls = __builtin_amdgcn_readfirstlane(ncls); cls = __builtin_amdgcn_readfirstlane(cls); crank = __builtin_amdgcn_readfirstlane(crank); csize = __builtin_amdgcn_readfirstlane(csize);
    }
    if constexpr (last < 1) return;

    {
        pg8::Gemm g{(const bf16_t*)(ws + WS_XN), (const bf16_t*)(ws + WS_W1T), T_TOK, N1F, 512}; pg8::StaticOrder S; S.init(T_TOK, N1F, G, bid);
        EpiRoute E{ws, 0, nullptr, 0, 0};
        pg8::gemm_phase<EpiRoute, pg8::StaticOrder, false, XW_E8M0>(lds, g, S, E, wave);
    }
    {
        pg8::Gemm g{(const bf16_t*)p.out, (const bf16_t*)(ws + WS_W1TB), T_TOK, N1B, 1024}; pg8::StaticOrder S; S.init(T_TOK, N1B, G, bid);
        EpiRoute E{ws, 0, nullptr, 0, N1F / 256};
        pg8::gemm_phase<EpiRoute, pg8::StaticOrder>(lds, g, S, E, wave);
    }
    {
        pg8::Gemm g{(const bf16_t*)(ws + WS_MN), (const bf16_t*)(ws + WS_WKVT), NBATCH * MEMT, 2048, 1024}; pg8::StaticOrder S; S.init(NBATCH * MEMT, 2048, G, (bid + G / 2) % G);
        EpiRoute E{ws, 1, (bf16_t*)(ws + WS_MKV), 2048, 0};
        pg8::gemm_phase<EpiRoute, pg8::StaticOrder>(lds, g, S, E, wave);
    }
    GRID_SYNC();

    if constexpr (last < 2) return;
    for (int t = gw; t < T_TOK; t += 4 * NGW) kprep_tokens<4>(p, t, NGW, lane);
    for (int m = gw; m < NBATCH * MEMT; m += NGW) mkprep_token(p, m, lane);
    {
        LAS float* scr = (LAS float*)(lds + wave * 16384);
        for (int it = gw; it < 1024; it += NGW) { const int bh = it >> 5, kb = (it >> 3) & 3, nb = it & 7, b = bh >> 2, hm = bh & 3;
            const bf16_t* src = (const bf16_t*)(ws + WS_MKV) + (size_t)(b * 256) * 2048 + 1024 + hm * 256;
            auto ld = [src](int k, int n) -> float { return bf2f(src[(size_t)k * 2048 + n]); };
            transpose_item(ld, (bf16_t*)(ws + WS_MVT) + (size_t)bh * 65536, 256, kb * 64, nb * 32, scr, lane); }
    }
    if constexpr (last == 2 && SUB == 0) return;
    __syncthreads(); lane = fresh_lane();
    for (int it = gw; it < 4096; it += NGW) lru_item<false>(p, lds + wave * LRU_WLDS, it, lane);
    GRID_SYNC();

    if constexpr (last < 3) return;
#ifdef IDRY
    indexer_phase<IDRY>(p, lds, bid, G, lane, wave);
    __syncthreads();
#endif
    indexer_phase<0>(p, lds, bid, G, lane, wave);
    if constexpr (last == 3 && SUB == 0) return;
    __syncthreads(); lane = fresh_lane();
    for (int it = gw; it < 2048; it += NGW) lru_apply_item(p, it, lane);
    if constexpr (last == 3 && SUB == 1) return;
    __syncthreads(); lane = fresh_lane();
    for (int it = bid; it < 1024; it += G) memattn_block(p, lds, it, lane, wave);
    GRID_SYNC();

    if constexpr (last < 4) return;
#ifdef ADRY
    attn_phase<ADRY>(p, lds + wave * ATT_WLDS, ncls, cls, crank * NWAVES + wave, csize * NWAVES, lane);
    __syncthreads();
#endif
    attn_phase<0>(p, lds + wave * ATT_WLDS, ncls, cls, crank * NWAVES + wave, csize * NWAVES, lane);
    GRID_SYNC();

    if constexpr (last < 5) return;
    {
        pg8::Gemm g{(const bf16_t*)(ws + WS_XN), (const bf16_t*)(ws + WS_WGT), T_TOK, NGATE, 512}; pg8::StaticOrder S; S.init(T_TOK, NGATE, G, bid);
        EpiMerge E{(const bf16_t*)(ws + WS_GG), (const bf16_t*)(ws + WS_Q), (const bf16_t*)(ws + WS_MQ), (bf16_t*)(ws + WS_MG)};
        pg8::gemm_phase<EpiMerge, pg8::StaticOrder, true, XW_E8M0>(lds, g, S, E, wave);
    }
    GRID_SYNC();

    if constexpr (last < 6) return;
    {
        pg8::Gemm g{(const bf16_t*)(ws + WS_MG), (const bf16_t*)(ws + WS_WOT), T_TOK, 1024, 1024}; pg8::StaticOrder S; S.init(T_TOK, 1024, G, bid);
        EpiOut E{p.x, p.out};
        pg8::gemm_phase<EpiOut, pg8::StaticOrder>(lds, g, S, E, wave);
    }
    for (int r = gw; r < 2 * 16384; r += NGW) { const int which = r >= 16384, rr = r & 16383;
        quant_row_fp8((which ? p.peer_v : p.peer_u) + (size_t)rr * 1024, ws + (which ? WS_V8 : WS_U8) + (size_t)rr * 128, (float*)(ws + WS_UVINV) + 2 * rr + which, lane); }
    GRID_SYNC();

    if constexpr (last < 7) return;
    for (int m = gw; m < T_TOK; m += NGW) rms_rows_to_bf16<1, NOISEQ>(p.out, ((const float*)(ws + WS_CONST)) + C_NFFN, (bf16_t*)(ws + WS_XN), m, NGW, T_TOK, lane);
    GRID_SYNC();

    if constexpr (last < 8) return;
    {
        pg8::Gemm g{(const bf16_t*)(ws + WS_XN), (const bf16_t*)(ws + WS_WQT), T_TOK, 2048, 1024}; pg8::StaticOrder S; S.init(T_TOK, 2048, G, bid);
        EpiRoute E{ws, 1, (bf16_t*)(ws + WS_PQ), 2048, 0};
        pg8::gemm_phase<EpiRoute, pg8::StaticOrder>(lds, g, S, E, wave);
    }
    GRID_SYNC();

    if constexpr (last < 9) return;
    peer_route_phase(p, lds, bid, G, wave, lane);
    GRID_SYNC();

    if constexpr (last < 10) return;
    {
        const int nc = ncls, cw = crank * NWAVES + wave, ncw = csize * NWAVES;
#ifndef ZREP
#define ZREP 1
#endif
#ifdef ZDRY
        for (int x = cls; x < 8; x += nc) peer_zpart_class<ZDRY>(p, lds + wave * PZ_WLDS, x, cw, ncw, lane);
        __syncthreads();
#endif
        for (int x = cls; x < 8; x += nc)
            peer_zpart_class<0xffff>(p, lds + wave * PZ_WLDS, x, cw, ncw, lane);
        GRID_SYNC();
        for (int t = gw; t < T_TOK; t += NGW) peer_act_token(p, t, lane);
        GRID_SYNC();
        for (int x = cls; x < 8; x += nc)
            peer_out_class(p, lds + wave * PO_WLDS, x, cw, ncw, lane);
    }
  }
}

extern "C" void kernel_launch(void* const* d_in, const int* in_sizes, int n_in, void* d_out, int out_size, void* d_ws, size_t ws_size, hipStream_t stream) {
    static int grid_blocks = 0;
    if (grid_blocks == 0) {
        if (n_in != 24 || out_size != T_TOK * DM || ws_size < WS_END) { fprintf(stderr, "kernel_launch: unexpected problem (n_in %d, out %d, ws %zu)\n", n_in, out_size, ws_size); grid_blocks = -1; return; }
        int dev = 0, cus = 0, per_cu = 0;
        hipGetDevice(&dev);
        hipDeviceGetAttribute(&cus, hipDeviceAttributeMultiprocessorCount, dev);
        if (hipFuncSetAttribute((const void*)fwd_megakernel<10>, hipFuncAttributeMaxDynamicSharedMemorySize, LDS_TOTAL) != hipSuccess) { fprintf(stderr, "kernel_launch: hipFuncSetAttribute failed\n"); grid_blocks = -1; return; }
        if (hipOccupancyMaxActiveBlocksPerMultiprocessor(&per_cu, (const void*)fwd_megakernel<10>, NTHREADS, LDS_TOTAL) != hipSuccess || per_cu < 1) { fprintf(stderr, "kernel_launch: occupancy query says %d\n", per_cu); per_cu = 1; }
        (void)hipGetLastError();
        grid_blocks = cus;
    }
    if (grid_blocks < 0) return;
    Params p{};
    const float* const* in = (const float* const*)d_in;
    p.x = in[0]; p.mem = in[1]; p.norm_mix = in[2]; p.w_in = in[3]; p.conv_w = in[4]; p.conv_b = in[5];
    p.lru_wa = in[6]; p.lru_ba = in[7]; p.lru_wi = in[8]; p.lru_bi = in[9]; p.lru_lambda = in[10];
    p.q_norm = in[11]; p.k_norm = in[12]; p.idx_k_norm = in[13]; p.mem_norm = in[14]; p.w_mem_kv = in[15];
    p.mem_q_norm = in[16]; p.mem_k_norm = in[17]; p.w_out = in[18]; p.norm_ffn = in[19]; p.peer_wq = in[20];
    p.peer_subkeys = in[21]; p.peer_u = in[22]; p.peer_v = in[23];
    p.out = (float*)d_out; p.ws = (unsigned char*)d_ws;
    (void)hipMemsetAsync((char*)d_ws + WS_CTL, 0, 32768, stream);
    void* args[] = {&p};
#ifdef PROBE_K
#ifndef PROBE_SUB
#define PROBE_SUB 9
#endif
    { static bool once = false; if (!once) { once = true; (void)hipFuncSetAttribute((const void*)fwd_megakernel<PROBE_K, PROBE_SUB>, hipFuncAttributeMaxDynamicSharedMemorySize, LDS_TOTAL); }
      (void)hipLaunchCooperativeKernel((const void*)fwd_megakernel<PROBE_K, PROBE_SUB>, dim3(grid_blocks), dim3(NTHREADS), args, LDS_TOTAL, stream);
      (void)hipMemsetAsync((char*)d_ws + WS_CTL, 0, 32768, stream); }
#endif
    hipError_t e = hipLaunchCooperativeKernel((const void*)fwd_megakernel<10>, dim3(grid_blocks), dim3(NTHREADS), args, LDS_TOTAL, stream);
    if (e != hipSuccess) fprintf(stderr, "kernel_launch: cooperative launch failed: %s (grid %d)\n", hipGetErrorString(e), grid_blocks);
}
```

```cpp
#include <hip/hip_runtime.h>
#include <hip/hip_cooperative_groups.h>
#include <cstdio>
namespace cg = cooperative_groups;

#define LAS __attribute__((address_space(3)))
#define LDS_WAIT() asm volatile("s_waitcnt lgkmcnt(0)" ::: "memory")
typedef unsigned short bf16_t;
typedef short bf16x8 __attribute__((ext_vector_type(8)));
typedef float f32x4 __attribute__((ext_vector_type(4)));
typedef float f32x2 __attribute__((ext_vector_type(2)));
typedef unsigned u32x4 __attribute__((ext_vector_type(4)));
typedef unsigned u32x2 __attribute__((ext_vector_type(2)));

constexpr int T_TOK = 32768, DM = 1024, SEQ = 4096, NBATCH = 8, MEMT = 256;
constexpr int N1 = 5376;
constexpr int NGATE = 4096;
constexpr int NWAVES = 8, NTHREADS = 512;
constexpr float EPS = 1e-6f;

constexpr size_t MiB = 1ull << 20;
constexpr size_t WS_CTL = 0;
constexpr size_t WS_CONST = 65536;
constexpr int C_CONVW = 0, C_CONVB = 4096, C_LBA = 5120, C_LBI = 6144, C_LAM = 7168, C_QN = 8192, C_KN = 8320, C_IKN = 8448, C_MQN = 8512, C_MKN = 8768, C_NFFN = 9024, C_END = 10048;
constexpr size_t WS_ROPE64 = 1 * MiB;
constexpr size_t WS_ROPE32 = 3 * MiB;
constexpr size_t WS_LRUS = 4 * MiB;
constexpr size_t WS_WAT = 6 * MiB;
constexpr size_t WS_WIT = 6 * MiB + 256 * 1024;
constexpr size_t WS_SUBK = 7 * MiB;
constexpr size_t WS_MN = 8 * MiB;
constexpr size_t WS_MKV = 12 * MiB;
constexpr size_t WS_MKN = 20 * MiB;
constexpr size_t WS_MVT = 24 * MiB;
constexpr size_t WS_W1T = 28 * MiB;
constexpr size_t WS_W1TB = 34 * MiB;
constexpr int N1F = 4608, N1B = 768;
constexpr size_t WS_WGT = 40 * MiB;
constexpr size_t WS_WOT = 48 * MiB;
constexpr size_t WS_WKVT = 50 * MiB;
constexpr size_t WS_WQT = 54 * MiB;
constexpr size_t WS_KN = 60 * MiB;
constexpr size_t WS_KIN = 76 * MiB;
constexpr size_t WS_IDX = 80 * MiB;
constexpr size_t WS_XN = 96 * MiB;
constexpr size_t WS_LX = 160 * MiB;
constexpr size_t WS_GG = 224 * MiB;
constexpr size_t WS_Q = 288 * MiB;
constexpr size_t WS_MQ = 352 * MiB;
constexpr size_t WS_KR = 416 * MiB;
constexpr size_t WS_V = 432 * MiB;
constexpr size_t WS_QI = 448 * MiB;
constexpr size_t WS_KW = 480 * MiB;
constexpr size_t WS_K8 = 496 * MiB;
constexpr size_t WS_END = 504 * MiB;
constexpr float K8_SCALE = 8.0f;
constexpr float X8_SCALE = 8.0f, W8_SCALE = 64.0f;
constexpr int   XW_E8M0 = 127 - 3 - 6;
constexpr size_t WS_MG = WS_LX;
constexpr size_t WS_PQ = WS_LX;
constexpr size_t WS_UB = WS_Q;
constexpr size_t WS_VB = WS_Q + 32 * MiB;
constexpr size_t WS_EIDX = WS_MQ;
constexpr size_t WS_EG = WS_MQ + 16 * MiB;

constexpr int LDS_BYTES = 156672;
constexpr int LDS_XB_OFF = LDS_BYTES, LDS_TOTAL = LDS_BYTES + 16;

struct Params {
    const float* x; const float* mem; const float* norm_mix; const float* w_in; const float* conv_w; const float* conv_b;
    const float* lru_wa; const float* lru_ba; const float* lru_wi; const float* lru_bi; const float* lru_lambda;
    const float* q_norm; const float* k_norm; const float* idx_k_norm; const float* mem_norm; const float* w_mem_kv;
    const float* mem_q_norm; const float* mem_k_norm; const float* w_out; const float* norm_ffn; const float* peer_wq;
    const float* peer_subkeys; const float* peer_u; const float* peer_v;
    float* out; unsigned char* ws;
};

typedef float f32x2_t_ __attribute__((ext_vector_type(2)));
typedef __bf16 bf16x2_t_ __attribute__((ext_vector_type(2)));
__device__ __forceinline__ unsigned pk2(float lo, float hi) { const f32x2_t_ v = {lo, hi}; const bf16x2_t_ b = __builtin_convertvector(v, bf16x2_t_); return __builtin_bit_cast(unsigned, b); }
__device__ __forceinline__ unsigned f2bf(float f) { return (unsigned)__builtin_bit_cast(unsigned short, (__bf16)f); }
__device__ __forceinline__ float bf2f(unsigned short b) { return __uint_as_float(((unsigned)b) << 16); }
__device__ __forceinline__ float bflo(unsigned u) { return __uint_as_float(u << 16); }
__device__ __forceinline__ float bfhi(unsigned u) { return __uint_as_float(u & 0xffff0000u); }
__device__ __forceinline__ float frcp(float x) { return __builtin_amdgcn_rcpf(x); }
__device__ __forceinline__ float sigmoidf_(float x) { return frcp(1.0f + __expf(-x)); }
__device__ __forceinline__ float gelu_tanh(float x) { const float u = 1.5957691216057308f * (x + 0.044715f * x * x * x); return x * frcp(1.0f + __expf(-u)); }
__device__ __forceinline__ float wave_sum(float v) {
#pragma unroll
    for (int o = 1; o < 64; o <<= 1) v += __shfl_xor(v, o);
    return v;
}
__device__ __forceinline__ bf16x8 pack8(const float* v) {
    u32x4 w; w.x = pk2(v[0], v[1]); w.y = pk2(v[2], v[3]); w.z = pk2(v[4], v[5]); w.w = pk2(v[6], v[7]);
    return __builtin_bit_cast(bf16x8, w);
}
__device__ __forceinline__ void unpack8(u32x4 w, float* v) {
    v[0] = bflo(w.x); v[1] = bfhi(w.x); v[2] = bflo(w.y); v[3] = bfhi(w.y); v[4] = bflo(w.z); v[5] = bfhi(w.z); v[6] = bflo(w.w); v[7] = bfhi(w.w);
}
__device__ __forceinline__ int fresh_lane() { unsigned m = 0xffffffffu; asm volatile("" : "+s"(m)); return (int)__builtin_amdgcn_mbcnt_hi(m, __builtin_amdgcn_mbcnt_lo(m, 0u)); }
#define MFMA16(a, b, c) __builtin_amdgcn_mfma_f32_16x16x32_bf16((a), (b), (c), 0, 0, 0)


#define XB_TMO      128
#define XB_XCNT(j)  (256  + 64 * (j))
#define XB_XSUB(j)  (1280 + 64 * (j))
#define XB_XGEN(j)  (2304 + 64 * (j))
#define XB_TOP      3328
#define XB_TOPGEN   3392
#define XCD_BAR_WORDS 3456
#define XB_SPIN_CAP (1u << 23)
__device__ __forceinline__ unsigned xb_ld(unsigned* p)              { return __hip_atomic_load(p, __ATOMIC_RELAXED, __HIP_MEMORY_SCOPE_AGENT); }
__device__ __forceinline__ unsigned xb_add(unsigned* p, unsigned v) { return __hip_atomic_fetch_add(p, v, __ATOMIC_RELAXED, __HIP_MEMORY_SCOPE_AGENT); }
__device__ __forceinline__ unsigned xb_xcc_id() { return (unsigned)__builtin_amdgcn_s_getreg((3 << 11) | 20) & 0xFu; }
#define XB_SPIN(cond, bar) do { unsigned _sp = 0; while (cond) { __builtin_amdgcn_s_sleep(1); \
    if ((++_sp & 255u) == 0u) { if (xb_ld(&(bar)[XB_TMO])) break; if (_sp > XB_SPIN_CAP) { atomicAdd(&(bar)[XB_TMO], 1u); break; } } } } while (0)
struct XcdBarrier { unsigned* bar; unsigned x; volatile LAS unsigned* st; };
__device__ __forceinline__ XcdBarrier xcd_barrier_post(unsigned* bar, volatile LAS unsigned* st, int wave_id) {
    XcdBarrier b; b.bar = bar; b.x = xb_xcc_id(); b.st = st;
    if (wave_id == 0 && fresh_lane() == 0) (void)xb_add(&bar[XB_XCNT(b.x)], 1u);
    return b;
}
__device__ __forceinline__ void xcd_barrier_complete(unsigned* bar, unsigned x, unsigned& nloc, unsigned& nx) {
    const unsigned G = gridDim.x * gridDim.y * gridDim.z;
    unsigned sum, cnt, mine, sp = 0u;
    for (;;) {
        sum = 0u; cnt = 0u; mine = 0u;
#pragma unroll
        for (unsigned j = 0; j < 16; ++j) { const unsigned c = xb_ld(&bar[XB_XCNT(j)]); sum += c; cnt += (c > 0u) ? 1u : 0u; mine = (j == x) ? c : mine; }
        if (sum == G) break;
        __builtin_amdgcn_s_sleep(1);
        if ((++sp & 255u) == 0u) { if (xb_ld(&bar[XB_TMO])) break; if (sp > XB_SPIN_CAP) { atomicAdd(&bar[XB_TMO], 1u); break; } }
    }
    nloc = mine > 0u ? mine : 1u; nx = cnt > 0u ? cnt : 1u;
}
__device__ __forceinline__ void xcd_barrier(const XcdBarrier& b, int wave_id) {
    asm volatile("s_waitcnt vmcnt(0)" ::: "memory");
    __syncthreads();
    if (wave_id == 0 && fresh_lane() == 0) {
        unsigned* bar = b.bar;
        __builtin_amdgcn_s_waitcnt(0);
        unsigned nloc = b.st[0], nx = b.st[1];
        if (nloc == 0u) { xcd_barrier_complete(bar, b.x, nloc, nx); b.st[0] = nloc; b.st[1] = nx; }
        const unsigned old = xb_add(&bar[XB_XSUB(b.x)], 1u);
        const unsigned gen = old / nloc;
        if (old + 1u == (gen + 1u) * nloc) {
            __builtin_amdgcn_fence(__ATOMIC_RELEASE, "agent");
            asm volatile("s_waitcnt vmcnt(0)" ::: "memory");
            const unsigned og = xb_add(&bar[XB_TOP], 1u);
            const unsigned tg = og / nx;
            if (og + 1u == (tg + 1u) * nx) xb_add(&bar[XB_TOPGEN], 1u);
            else XB_SPIN(xb_ld(&bar[XB_TOPGEN]) == tg, bar);
            __builtin_amdgcn_fence(__ATOMIC_ACQUIRE, "agent");
            xb_add(&bar[XB_XGEN(b.x)], 1u);
            asm volatile("s_waitcnt vmcnt(0)" ::: "memory");
        } else {
            XB_SPIN(xb_ld(&bar[XB_XGEN(b.x)]) == gen, bar);
            __builtin_amdgcn_fence(__ATOMIC_ACQUIRE, "agent");
            asm volatile("s_waitcnt vmcnt(0)" ::: "memory");
        }
    }
    __syncthreads();
}

namespace pg8 {
typedef int i32x4_t __attribute__((ext_vector_type(4)));
typedef int i32x8_t __attribute__((ext_vector_type(8)));
__device__ __forceinline__ i32x8_t cat8(bf16x8 a, bf16x8 b) { return __builtin_shufflevector(__builtin_bit_cast(i32x4_t, a), __builtin_bit_cast(i32x4_t, b), 0, 1, 2, 3, 4, 5, 6, 7); }
constexpr int BM = 256, BK = 64, HALF = 128, HTB = HALF * BK * 2, STAGE_BYTES = 8 * HTB, NXCD = 8, WGM = 8;
__host__ __device__ __forceinline__ int lds_byte(int r, int c) { const int st = (r >> 4) * 2 + (c >> 5), rr = r & 15, cc = c & 31, ob = rr * 64 + cc * 2; return st * 1024 + (ob ^ (((ob >> 9) & 1) << 5)); }
__host__ __device__ __forceinline__ void stage_rc(int b, int& R, int& C) { const int st = b / 1024, sb = b % 1024, swz = sb ^ (((sb >> 9) & 1) << 5); R = (st >> 1) * 16 + swz / 64; C = (st & 1) * 32 + (swz % 64) / 2; }
__host__ __device__ __forceinline__ int perm32(int rho) { const int n = rho >> 4, i = rho & 15; return 8 * (i >> 2) + 4 * n + (i & 3); }
struct Unit { int pm, pn; };
struct Gemm { const bf16_t* A; const bf16_t* Bt; int M, N, K; };
struct StaticOrder {
    int nM, nN, nwg, G, c;
    __host__ __device__ void init(int M, int N, int G_, int c_) { nM = M / BM; nN = N / BM; nwg = nM * nN; G = G_; c = c_; }
    __host__ __device__ bool next(int i, Unit& u) const {
        const long L = (long)i * G + c; if (L >= nwg) return false;
        int wgid = (int)L; { const int q = nwg / NXCD, r = nwg % NXCD, xcd = wgid % NXCD, off = wgid / NXCD; wgid = (xcd < r ? xcd * (q + 1) : r * (q + 1) + (xcd - r) * q) + off; }
        const int nig = WGM * nN, gid = wgid / nig, fm = gid * WGM, gsz = (nM - fm) < WGM ? (nM - fm) : WGM;
        u.pm = fm + ((wgid % nig) % gsz); u.pn = (wgid % nig) / gsz; return true;
    }
    __device__ __forceinline__ void a_ready(const Unit&) const {}
    __device__ __forceinline__ void done(const Unit&) const {}
};

template <class Epi, class Sched, bool SKIPQ = false, int F8SC = 0>
__device__ __forceinline__ void gemm_phase(LAS unsigned char* lds, const Gemm g, const Sched& S, const Epi& E, int wave_id) {
    const int tid = (wave_id << 6) | fresh_lane(), wid = wave_id, lane = tid & 63, wr = wid >> 2, wc = wid & 3, fr = lane & 15, fq = lane >> 4;
    const int K = g.K, nt = K / BK;
    unsigned voffA[2], voffB[2];
#pragma unroll
    for (int i = 0; i < 2; ++i) { int R, C; stage_rc(tid * 16 + i * 8192, R, C); const int Rb = Epi::PERM ? ((R & ~31) + perm32(R & 31)) : R;
        voffA[i] = (unsigned)(R * K + C) * 2u; voffB[i] = (unsigned)(Rb * K + C) * 2u; }
    const size_t kstep = (size_t)(BK * 2);
    const size_t hstep = (size_t)HALF * K * 2;
    const size_t tstep = 2 * hstep;
    const unsigned ldsw = (unsigned)wid * 1024u;
    const int aoff = lds_byte(wr * 64 + fr, fq * 8), boff = lds_byte(wc * 32 + fr, fq * 8);
#define PG8_SA(b, h) (((b) * 2 + (h)) * HTB)
#define PG8_SB(b, h) ((4 + (b) * 2 + (h)) * HTB)
#define PG8_STAGE(bufoff, gbase, voff) do { _Pragma("unroll") for (int _i = 0; _i < 2; ++_i) \
        __builtin_amdgcn_global_load_lds((const unsigned*)((const char*)(gbase) + (voff)[_i]), (LAS unsigned*)(lds + (bufoff) + ldsw + _i * 8192), 16, 0, 0); } while (0)
#define PG8_LDA(dst, b, h) do { _Pragma("unroll") for (int m = 0; m < 4; ++m) dst[m] = __builtin_shufflevector(*(const LAS i32x4_t*)(lds + PG8_SA(b, h) + aoff + m * 2048), *(const LAS i32x4_t*)(lds + PG8_SA(b, h) + aoff + m * 2048 + 1024), 0, 1, 2, 3, 4, 5, 6, 7); } while (0)
#define PG8_LDB(dst, b, h) do { _Pragma("unroll") for (int n = 0; n < 2; ++n) dst[n] = __builtin_shufflevector(*(const LAS i32x4_t*)(lds + PG8_SB(b, h) + boff + n * 2048), *(const LAS i32x4_t*)(lds + PG8_SB(b, h) + boff + n * 2048 + 1024), 0, 1, 2, 3, 4, 5, 6, 7); } while (0)
#define PG8_HALF(v, k) __builtin_bit_cast(bf16x8, __builtin_shufflevector((v), (v), 4 * (k), 4 * (k) + 1, 4 * (k) + 2, 4 * (k) + 3))
#define PG8_MMA(ai, bj, At, Bt) do { __builtin_amdgcn_s_setprio(1); _Pragma("unroll") for (int m = 0; m < 4; ++m) _Pragma("unroll") for (int n = 0; n < ((SKIPQ && (bj) == 1) ? 1 : 2); ++n) { \
        if constexpr (F8SC != 0) asm volatile("v_mfma_scale_f32_16x16x128_f8f6f4 %0, %1, %2, %0, %3, %4 op_sel_hi:[0,0,0]" : "+v"(acc[ai][bj][m][n]) : "v"(Bt[n]), "v"(At[m]), "v"(sclA), "v"(sclB)); \
        else { acc[ai][bj][m][n] = __builtin_amdgcn_mfma_f32_16x16x32_bf16(PG8_HALF(Bt[n], 0), PG8_HALF(At[m], 0), acc[ai][bj][m][n], 0, 0, 0); \
               acc[ai][bj][m][n] = __builtin_amdgcn_mfma_f32_16x16x32_bf16(PG8_HALF(Bt[n], 1), PG8_HALF(At[m], 1), acc[ai][bj][m][n], 0, 0, 0); } } __builtin_amdgcn_s_setprio(0); } while (0)
#define PG8_WAIT_V(n) asm volatile("s_waitcnt vmcnt(" #n ")" ::: "memory")
#define PG8_WAIT_L(n) asm volatile("s_waitcnt lgkmcnt(" #n ")" ::: "memory")
#define PG8_BAR __builtin_amdgcn_s_barrier()
#define PG8_SCHED __builtin_amdgcn_sched_barrier(0)
    Unit cur, nxt; int ui = 0;
    if (!S.next(0, cur)) return;
    int sclA = F8SC * 0x01010101, sclB = 0x7f7f7f7f;
    if constexpr (F8SC != 0) asm volatile("" : "+v"(sclA), "+v"(sclB));
    f32x4 acc[2][2][4][2];
#pragma unroll
    for (int a = 0; a < 2; ++a)
#pragma unroll
        for (int b = 0; b < 2; ++b)
#pragma unroll
            for (int m = 0; m < 4; ++m)
#pragma unroll
                for (int n = 0; n < 2; ++n) acc[a][b][m][n] = (f32x4){0.f, 0.f, 0.f, 0.f};
    i32x8_t At[4], B0[2], B1[2];
    const char* cA = (const char*)g.A + (size_t)cur.pm * tstep; const char* cB = (const char*)g.Bt + (size_t)cur.pn * tstep;
    S.a_ready(cur);
    PG8_STAGE(PG8_SB(0, 0), cB, voffB); PG8_STAGE(PG8_SA(0, 0), cA, voffA); PG8_STAGE(PG8_SB(0, 1), cB + hstep, voffB); PG8_STAGE(PG8_SA(0, 1), cA + hstep, voffA);
    if (wr == 1) PG8_BAR;
    PG8_WAIT_V(4); PG8_BAR;
    PG8_STAGE(PG8_SB(1, 0), cB + kstep, voffB); PG8_STAGE(PG8_SA(1, 0), cA + kstep, voffA); PG8_STAGE(PG8_SB(1, 1), cB + hstep + kstep, voffB);
    PG8_WAIT_V(6); PG8_BAR;
    for (;;) {
        const bool has_next = S.next(ui + 1, nxt);
        const char* nA = has_next ? (const char*)g.A + (size_t)nxt.pm * tstep : cA; const char* nB = has_next ? (const char*)g.Bt + (size_t)nxt.pn * tstep : cB;
#pragma unroll 1
        for (int t = 0; t < nt; t += 2) {
            const bool last = (t == nt - 2);
            const char* a1 = cA + (size_t)(t + 1) * kstep;
            const char* a2 = last ? nA : cA + (size_t)(t + 2) * kstep; const char* b2 = last ? nB : cB + (size_t)(t + 2) * kstep;
            const char* a3 = a2 + kstep; const char* b3 = b2 + kstep;
            if (last && has_next) S.a_ready(nxt);
            PG8_LDB(B0, 0, 0); PG8_SCHED; PG8_LDA(At, 0, 0); PG8_STAGE(PG8_SA(1, 1), a1 + hstep, voffA);
            PG8_WAIT_L(8); PG8_BAR; PG8_WAIT_L(0); PG8_MMA(0, 0, At, B0); PG8_BAR; PG8_SCHED;
            PG8_LDB(B1, 0, 1); PG8_STAGE(PG8_SB(0, 0), b2, voffB);
            PG8_BAR; PG8_WAIT_L(0); PG8_MMA(0, 1, At, B1); PG8_BAR;
            PG8_LDA(At, 0, 1); PG8_STAGE(PG8_SA(0, 0), a2, voffA);
            PG8_BAR; PG8_WAIT_L(0); PG8_MMA(1, 0, At, B0); PG8_BAR; PG8_SCHED;
            PG8_STAGE(PG8_SB(0, 1), b2 + hstep, voffB);
            PG8_WAIT_V(6); PG8_BAR; PG8_MMA(1, 1, At, B1); PG8_BAR;
            PG8_LDB(B0, 1, 0); PG8_SCHED; PG8_LDA(At, 1, 0); PG8_STAGE(PG8_SA(0, 1), a2 + hstep, voffA);
            PG8_WAIT_L(8); PG8_BAR; PG8_WAIT_L(0); PG8_MMA(0, 0, At, B0); PG8_BAR; PG8_SCHED;
            PG8_LDB(B1, 1, 1); PG8_STAGE(PG8_SB(1, 0), b3, voffB);
            PG8_BAR; PG8_WAIT_L(0); PG8_MMA(0, 1, At, B1); PG8_BAR;
            PG8_LDA(At, 1, 1); PG8_STAGE(PG8_SA(1, 0), a3, voffA);
            PG8_BAR; PG8_WAIT_L(0); PG8_MMA(1, 0, At, B0); PG8_BAR; PG8_SCHED;
            PG8_STAGE(PG8_SB(1, 1), b3 + hstep, voffB);
            PG8_WAIT_V(6); PG8_BAR; PG8_MMA(1, 1, At, B1); PG8_BAR;
        }
        if constexpr (F8SC != 0) asm volatile("s_nop 15\n\ts_nop 7" ::: "memory");
        E(acc, cur, wr, wc, fr, fq); S.done(cur);
        if (!has_next) break;
#pragma unroll
        for (int a = 0; a < 2; ++a)
#pragma unroll
            for (int b = 0; b < 2; ++b)
#pragma unroll
                for (int m = 0; m < 4; ++m)
#pragma unroll
                    for (int n = 0; n < 2; ++n) acc[a][b][m][n] = (f32x4){0.f, 0.f, 0.f, 0.f};
        cur = nxt; cA = nA; cB = nB; ++ui;
    }
    PG8_WAIT_V(0);
    if (wr == 0) PG8_BAR;
    PG8_BAR;
#undef PG8_SA
#undef PG8_SB
#undef PG8_STAGE
#undef PG8_LDA
#undef PG8_LDB
#undef PG8_HALF
#undef PG8_MMA
#undef PG8_WAIT_V
#undef PG8_WAIT_L
#undef PG8_BAR
#undef PG8_SCHED
}
}

__device__ __forceinline__ unsigned cvt_pk_bf16(float lo, float hi) { unsigned r; asm volatile("v_cvt_pk_bf16_f32 %0, %1, %2" : "=v"(r) : "v"(lo), "v"(hi)); return r; }

struct EpiRoute {
    static constexpr bool PERM = true;
    unsigned char* ws; int mode; bf16_t* O; int ldc; int pn0 = 0;
    __device__ __forceinline__ void operator()(const f32x4 (&acc)[2][2][4][2], const pg8::Unit& u, int wr, int wc, int fr, int fq) const {
        const int row0 = u.pm * 256 + wr * 64 + fr;
        bf16_t* base; int ld, colt; bool gelu = false;
        if (mode == 0) {
            const int pn = u.pn + pn0;
            if (pn < 4) { base = (bf16_t*)(ws + WS_LX); ld = 1024; colt = pn * 256; }
            else if (pn < 8) { base = (bf16_t*)(ws + WS_GG); ld = 1024; colt = (pn - 4) * 256; gelu = true; }
            else if (pn < 12) { base = (bf16_t*)(ws + WS_Q); ld = 1024; colt = (pn - 8) * 256; }
            else if (pn < 16) { base = (bf16_t*)(ws + WS_MQ); ld = 1024; colt = (pn - 12) * 256; }
            else if (pn == 16) { base = (bf16_t*)(ws + WS_KR); ld = 256; colt = 0; }
            else if (pn == 17) { base = (bf16_t*)(ws + WS_V); ld = 256; colt = 0; }
            else if (pn < 20) { base = (bf16_t*)(ws + WS_QI); ld = 512; colt = (pn - 18) * 256; }
            else { base = (bf16_t*)(ws + WS_KW); ld = 256; colt = 0; }
        } else { base = O; ld = ldc; colt = u.pn * 256; }
        const int col0 = colt + wc * 32 + 8 * fq;
#pragma unroll
        for (int ai = 0; ai < 2; ++ai)
#pragma unroll
            for (int m = 0; m < 4; ++m) { bf16_t* rowp = base + (size_t)(row0 + ai * 128 + m * 16) * ld + col0;
#pragma unroll
                for (int bj = 0; bj < 2; ++bj) { f32x4 v0 = acc[ai][bj][m][0], v1 = acc[ai][bj][m][1];
                    if (gelu) {
#pragma unroll
                        for (int j = 0; j < 4; ++j) { v0[j] = gelu_tanh(v0[j]); v1[j] = gelu_tanh(v1[j]); } }
                    u32x4 w; w.x = cvt_pk_bf16(v0[0], v0[1]); w.y = cvt_pk_bf16(v0[2], v0[3]); w.z = cvt_pk_bf16(v1[0], v1[1]); w.w = cvt_pk_bf16(v1[2], v1[3]);
                    *(u32x4*)(rowp + bj * 128) = w; } }
    }
};

struct EpiMerge {
    static constexpr bool PERM = false;
    const bf16_t* Y0; const bf16_t* Y1; const bf16_t* Y2; bf16_t* MG;
    __device__ __forceinline__ void operator()(const f32x4 (&acc)[2][2][4][2], const pg8::Unit& u, int wr, int wc, int fr, int fq) const {
        const unsigned ch = (unsigned)(u.pn * 64 + wc * 16 + fq * 4);
        const unsigned off0 = (unsigned)(u.pm * 256 + wr * 64 + fr) * 1024u + ch;
        u32x2 y0[2][4], y1[2][4], y2[2][4];
#pragma unroll
        for (int ai = 0; ai < 2; ++ai)
#pragma unroll
            for (int m = 0; m < 4; ++m) { const unsigned off = off0 + (unsigned)(ai * 128 + m * 16) * 1024u;
                y0[ai][m] = *(const u32x2*)(Y0 + off); y1[ai][m] = *(const u32x2*)(Y1 + off); y2[ai][m] = *(const u32x2*)(Y2 + off); }
#pragma unroll
        for (int ai = 0; ai < 2; ++ai)
#pragma unroll
            for (int m = 0; m < 4; ++m) {
                const unsigned off = off0 + (unsigned)(ai * 128 + m * 16) * 1024u;
                const u32x2 a = y0[ai][m], b = y1[ai][m], c = y2[ai][m];
                const f32x4 g0 = acc[ai][0][m][0], g1 = acc[ai][0][m][1], g2 = acc[ai][1][m][0];
                float o[4];
                o[0] = sigmoidf_(g0[0]) * bflo(a.x) + sigmoidf_(g1[0]) * bflo(b.x) + sigmoidf_(g2[0]) * bflo(c.x);
                o[1] = sigmoidf_(g0[1]) * bfhi(a.x) + sigmoidf_(g1[1]) * bfhi(b.x) + sigmoidf_(g2[1]) * bfhi(c.x);
                o[2] = sigmoidf_(g0[2]) * bflo(a.y) + sigmoidf_(g1[2]) * bflo(b.y) + sigmoidf_(g2[2]) * bflo(c.y);
                o[3] = sigmoidf_(g0[3]) * bfhi(a.y) + sigmoidf_(g1[3]) * bfhi(b.y) + sigmoidf_(g2[3]) * bfhi(c.y);
                u32x2 w; w.x = pk2(o[0], o[1]); w.y = pk2(o[2], o[3]);
                *(u32x2*)(MG + off) = w;
            }
    }
};

struct EpiOut {
    static constexpr bool PERM = false;
    const float* X; float* OUT;
    __device__ __forceinline__ void operator()(const f32x4 (&acc)[2][2][4][2], const pg8::Unit& u, int wr, int wc, int fr, int fq) const {
        const unsigned off0 = (unsigned)(u.pm * 256 + wr * 64 + fr) * 1024u + (unsigned)(u.pn * 256 + wc * 32 + 4 * fq);
#pragma unroll
        for (int ai = 0; ai < 2; ++ai) {
            f32x4 xv[4][2][2];
#pragma unroll
            for (int m = 0; m < 4; ++m)
#pragma unroll
                for (int bj = 0; bj < 2; ++bj)
#pragma unroll
                    for (int n = 0; n < 2; ++n) xv[m][bj][n] = *(const f32x4*)(X + (off0 + (unsigned)(ai * 128 + m * 16) * 1024u + (unsigned)(bj * 128 + n * 16)));
#pragma unroll
            for (int m = 0; m < 4; ++m)
#pragma unroll
                for (int bj = 0; bj < 2; ++bj)
#pragma unroll
                    for (int n = 0; n < 2; ++n) *(f32x4*)(OUT + (off0 + (unsigned)(ai * 128 + m * 16) * 1024u + (unsigned)(bj * 128 + n * 16))) = xv[m][bj][n] + acc[ai][bj][m][n];
        }
    }
};

template <class Ld>
__device__ __forceinline__ void transpose_item(const Ld& ld, bf16_t* WT, int Kd, int k0, int n0, LAS float* scr, int lane) {
    float tv[32];
#pragma unroll
    for (int i = 0; i < 32; ++i) tv[i] = ld(k0 + 2 * i + (lane >> 5), n0 + (lane & 31));
#pragma unroll
    for (int i = 0; i < 32; ++i) scr[(2 * i + (lane >> 5)) * 33 + (lane & 31)] = tv[i];
    LDS_WAIT();
    const int c = lane & 7;
#pragma unroll
    for (int j = 0; j < 4; ++j) { const int n = (lane >> 3) + 8 * j; const LAS float* s = scr + (8 * c) * 33 + n;
        u32x4 o; o.x = pk2(s[0 * 33], s[1 * 33]); o.y = pk2(s[2 * 33], s[3 * 33]); o.z = pk2(s[4 * 33], s[5 * 33]); o.w = pk2(s[6 * 33], s[7 * 33]);
        *(u32x4*)(WT + (size_t)(n0 + n) * Kd + k0 + 8 * c) = o; }
    LDS_WAIT();
}
__device__ __forceinline__ unsigned pk4_fp8(float a, float b, float c, float d, float sc) {
    int w = 0; w = __builtin_amdgcn_cvt_pk_fp8_f32(__builtin_amdgcn_fmed3f(a * sc, -448.f, 448.f), __builtin_amdgcn_fmed3f(b * sc, -448.f, 448.f), w, false);
    w = __builtin_amdgcn_cvt_pk_fp8_f32(__builtin_amdgcn_fmed3f(c * sc, -448.f, 448.f), __builtin_amdgcn_fmed3f(d * sc, -448.f, 448.f), w, true); return (unsigned)w; }
template <class Ld>
__device__ __forceinline__ void transpose_item_f8(const Ld& ld, unsigned char* WT, int Kd, int k0, int n0, LAS float* scr, int lane, float sc) {
    float tv[32];
#pragma unroll
    for (int i = 0; i < 32; ++i) tv[i] = ld(k0 + 2 * i + (lane >> 5), n0 + (lane & 31));
#pragma unroll
    for (int i = 0; i < 32; ++i) scr[(2 * i + (lane >> 5)) * 33 + (lane & 31)] = tv[i];
    LDS_WAIT();
    const int c = lane & 7;
#pragma unroll
    for (int j = 0; j < 4; ++j) { const int n = (lane >> 3) + 8 * j; const LAS float* s = scr + (8 * c) * 33 + n;
        u32x2 o; o.x = pk4_fp8(s[0 * 33], s[1 * 33], s[2 * 33], s[3 * 33], sc); o.y = pk4_fp8(s[4 * 33], s[5 * 33], s[6 * 33], s[7 * 33], sc);
        *(u32x2*)(WT + (size_t)(n0 + n) * Kd + k0 + 8 * c) = o; }
    LDS_WAIT();
}
__device__ __forceinline__ void rms_row_to_fp8(const float* xbase, const float* gain, unsigned char* obase, bf16_t* bbase, int m, int lane, float sc) {
    const f32x4* gr = (const f32x4*)gain + lane; const f32x4* xr = (const f32x4*)(xbase + (size_t)m * 1024) + lane;
    f32x4 v[4], g[4];
#pragma unroll
    for (int j = 0; j < 4; ++j) v[j] = xr[64 * j];
#pragma unroll
    for (int j = 0; j < 4; ++j) g[j] = gr[64 * j];
    float s = 0.f;
#pragma unroll
    for (int j = 0; j < 4; ++j) s += (v[j].x * v[j].x + v[j].y * v[j].y) + (v[j].z * v[j].z + v[j].w * v[j].w);
    const float rstd = rsqrtf(wave_sum(s) * (1.f / 1024.f) + EPS) * sc;
    unsigned* o4 = (unsigned*)(obase + (size_t)m * 1024) + lane;
#pragma unroll
    for (int j = 0; j < 4; ++j) o4[64 * j] = pk4_fp8(v[j].x * g[j].x, v[j].y * g[j].y, v[j].z * g[j].z, v[j].w * g[j].w, rstd);
    if (bbase) { const float rs = rstd * (1.0f / sc); u32x2* o8 = (u32x2*)(bbase + (size_t)m * 1024) + lane;
#pragma unroll
        for (int j = 0; j < 4; ++j) { u32x2 w; w.x = pk2(v[j].x * rs * g[j].x, v[j].y * rs * g[j].y); w.y = pk2(v[j].z * rs * g[j].z, v[j].w * rs * g[j].w); o8[64 * j] = w; } }
}
template <int NB, int NQ = 0> __device__ __forceinline__ void rms_rows_to_bf16(const float* xbase, const float* gain, bf16_t* obase, int m0, int mstride, int mlimit, int lane) {
    const f32x4* gr = (const f32x4*)gain + lane;
    f32x4 v[NB][4]; int mk[NB];
#pragma unroll
    for (int k = 0; k < NB; ++k) { const int m = m0 + k * mstride < mlimit ? m0 + k * mstride : m0; mk[k] = m; const f32x4* xr = (const f32x4*)(xbase + (size_t)m * 1024) + lane;
#pragma unroll
        for (int j = 0; j < 4; ++j) v[k][j] = xr[64 * j]; }
    f32x4 g[4];
#pragma unroll
    for (int j = 0; j < 4; ++j) g[j] = gr[64 * j];
#pragma unroll
    for (int k = 0; k < NB; ++k) { float s = 0.f;
#pragma unroll
        for (int j = 0; j < 4; ++j) s += (v[k][j].x * v[k][j].x + v[k][j].y * v[k][j].y) + (v[k][j].z * v[k][j].z + v[k][j].w * v[k][j].w);
        const float rstd = rsqrtf(wave_sum(s) * (1.f / 1024.f) + EPS);
        u32x2* o8 = (u32x2*)(obase + (size_t)mk[k] * 1024) + lane;
#pragma unroll
        for (int j = 0; j < 4; ++j) { float a0 = v[k][j].x * rstd * g[j].x, a1 = v[k][j].y * rstd * g[j].y, a2 = v[k][j].z * rstd * g[j].z, a3 = v[k][j].w * rstd * g[j].w;
            if (NQ) { a0 = __uint_as_float((__float_as_uint(a0) + 0x00020000u) & 0xFFFC0000u); a1 = __uint_as_float((__float_as_uint(a1) + 0x00020000u) & 0xFFFC0000u); a2 = __uint_as_float((__float_as_uint(a2) + 0x00020000u) & 0xFFFC0000u); a3 = __uint_as_float((__float_as_uint(a3) + 0x00020000u) & 0xFFFC0000u); }
            u32x2 w; w.x = pk2(a0, a1); w.y = pk2(a2, a3); o8[64 * j] = w; } }
}

__device__ __forceinline__ void phase_prologue(const Params& p, LAS unsigned char* lds, int lane, int wave, int gw, int NGW) {
    LAS float* scr = (LAS float*)(lds + wave * 16384);
    unsigned char* ws = p.ws;
    constexpr int I_W1 = 16 * (N1 / 32), I_WG = 16 * (NGATE / 32), I_WO = 16 * 32, I_WKV = 16 * 64, I_WQ = 16 * 64, I_LRU = 16 * 2 * 2;
    constexpr int NITEMS = I_W1 + I_WG + I_WO + I_WKV + I_WQ + I_LRU;
#ifndef PDUP
#define PDUP 0
#endif
#pragma unroll 1
    for (int rep_ = 0; rep_ < (PDUP == 1 ? 2 : 1); ++rep_)
    for (int it = gw; it < NITEMS; it += NGW) {
        int r = it;
        if (r < I_W1) { const int kb = r / (N1 / 32), nb = r % (N1 / 32); const float* W = p.w_in;
            auto ld = [W](int k, int n) -> float { int sc; if (n < 3072) sc = n; else if (n < 4096) sc = n + 1096; else if (n < 5192) sc = n - 1024; else sc = -1; return sc >= 0 ? W[(size_t)k * 8264 + sc] : 0.f; };
            if (nb < N1F / 32) transpose_item_f8(ld, ws + WS_W1T, 1024, kb * 64, nb * 32, scr, lane, W8_SCALE);
            else { auto ld2 = [&ld](int k, int n) -> float { return ld(k, n + N1F); }; transpose_item(ld2, (bf16_t*)(ws + WS_W1TB), 1024, kb * 64, nb * 32 - N1F, scr, lane); }
            continue; } r -= I_W1;
        if (r < I_WG) { const int kb = r / (NGATE / 32), nb = r % (NGATE / 32); const float* W = p.w_in;
            auto ld = [W](int k, int R) -> float { const int pn = R >> 8, bj = (R >> 7) & 1, wc = (R >> 5) & 3, n = (R >> 4) & 1, lo = R & 15; const int br = 2 * bj + n, ch = 64 * pn + 16 * wc + lo;
                return br < 3 ? W[(size_t)k * 8264 + 5192 + 1024 * br + ch] : 0.f; };
            transpose_item_f8(ld, ws + WS_WGT, 1024, kb * 64, nb * 32, scr, lane, W8_SCALE); continue; } r -= I_WG;
        if (r < I_WO) { const int kb = r / 32, nb = r % 32; const float* W = p.w_out;
            auto ld = [W](int k, int n) -> float { return W[(size_t)k * 1024 + n]; };
            transpose_item(ld, (bf16_t*)(ws + WS_WOT), 1024, kb * 64, nb * 32, scr, lane); continue; } r -= I_WO;
        if (r < I_WKV) { const int kb = r / 64, nb = r % 64; const float* W = p.w_mem_kv;
            auto ld = [W](int k, int n) -> float { return W[(size_t)k * 2048 + n]; };
            transpose_item(ld, (bf16_t*)(ws + WS_WKVT), 1024, kb * 64, nb * 32, scr, lane); continue; } r -= I_WKV;
        if (r < I_WQ) { const int kb = r / 64, nb = r % 64; const float* W = p.peer_wq;
            auto ld = [W](int k, int n) -> float { return W[(size_t)k * 2048 + n]; };
            transpose_item(ld, (bf16_t*)(ws + WS_WQT), 1024, kb * 64, nb * 32, scr, lane); continue; } r -= I_WQ;
        { const int which = r >> 5, blk = (r >> 1) & 15, nb = r & 1; const float* W = (which ? p.lru_wi : p.lru_wa) + blk * 4096;
            auto ld = [W](int k, int n) -> float { return W[k * 64 + n]; };
            transpose_item(ld, (bf16_t*)(ws + (which ? WS_WIT : WS_WAT)) + blk * 4096, 64, 0, nb * 32, scr, lane); }
    }
    { float* C = (float*)(ws + WS_CONST);
      for (int i = gw * 64 + lane; i < C_END; i += NGW * 64) { float v;
          if (i < C_CONVB) v = p.conv_w[i]; else if (i < C_LBA) v = p.conv_b[i - C_CONVB]; else if (i < C_LBI) v = p.lru_ba[i - C_LBA]; else if (i < C_LAM) v = p.lru_bi[i - C_LBI];
          else if (i < C_QN) v = p.lru_lambda[i - C_LAM]; else if (i < C_KN) v = p.q_norm[i - C_QN]; else if (i < C_IKN) v = p.k_norm[i - C_KN]; else if (i < C_MQN) v = p.idx_k_norm[i - C_IKN];
          else if (i < C_MKN) v = p.mem_q_norm[i - C_MQN]; else if (i < C_NFFN) v = p.mem_k_norm[i - C_MKN]; else v = p.norm_ffn[i - C_NFFN];
          C[i] = v; } }
    { const float* S = p.peer_subkeys; bf16_t* D = (bf16_t*)(ws + WS_SUBK);
      for (int i = gw * 64 + lane; i < 262144 / 4; i += NGW * 64) { const f32x4 v = ((const f32x4*)S)[i]; u32x2 w; w.x = pk2(v.x, v.y); w.y = pk2(v.z, v.w); ((u32x2*)D)[i] = w; } }
    { f32x2* R64 = (f32x2*)(ws + WS_ROPE64); f32x2* R32 = (f32x2*)(ws + WS_ROPE32);
#pragma unroll 1
      for (int rep_ = 0; rep_ < (PDUP == 3 ? 2 : 1); ++rep_)
      for (int e = gw * 64 + lane; e < 4096 * 96; e += NGW * 64) {
          const int pos = e / 96, i = e % 96; const bool is64 = i < 64; const int ii = is64 ? i : i - 64; const float half = is64 ? 64.f : 32.f;
          const float freq = exp2f(-(float)ii / half * 13.287712379549449f);
          const float angf = (float)pos * freq;
          const double a = (double)angf; const double kq = rint(a * 0.15915494309189535); const float rr = (float)(a - kq * 6.283185307179586);
          f32x2 cs; cs.x = __cosf(rr); cs.y = __sinf(rr);
          if (is64) R64[pos * 64 + ii] = cs; else R32[pos * 32 + ii] = cs; } }
#pragma unroll 1
    for (int rep_ = 0; rep_ < (PDUP == 2 ? 2 : 1); ++rep_)
    for (int m = gw; m < T_TOK; m += NGW) rms_row_to_fp8(p.x, p.norm_mix, ws + WS_XN, (bf16_t*)p.out, m, lane, X8_SCALE);
    for (int m = gw; m < NBATCH * MEMT; m += NGW) rms_rows_to_bf16<1>(p.mem, p.mem_norm, (bf16_t*)(ws + WS_MN), m, NGW, NBATCH * MEMT, lane);
}

template <int NB> __device__ __forceinline__ void kprep_tokens(const Params& p, int t0, int tstride, int lane) {
    unsigned char* ws = p.ws;
    const int g = lane >> 5, i = lane & 31, d = lane & 31;
    int tk[NB]; unsigned u0[NB], u1[NB]; float kx[NB], ky[NB]; f32x4 cs64[NB]; f32x2 cs32[NB];
    const float* C = (const float*)(ws + WS_CONST);
    const f32x2 ga = *(const f32x2*)(C + C_KN + 2 * i), gb = *(const f32x2*)(C + C_KN + 64 + 2 * i);
    const float gi0 = C[C_IKN + d], gi1 = C[C_IKN + d + 32];
#pragma unroll
    for (int k = 0; k < NB; ++k) { const int t = t0 + k * tstride < T_TOK ? t0 + k * tstride : t0; tk[k] = t; const int pos = t & (SEQ - 1);
        const bf16_t* src = (const bf16_t*)(ws + WS_KR) + (size_t)t * 256 + g * 128 + 2 * i; u0[k] = *(const unsigned*)src; u1[k] = *(const unsigned*)(src + 64);
        const bf16_t* sw = (const bf16_t*)(ws + WS_KW) + (size_t)t * 256; kx[k] = bf2f(sw[d]); ky[k] = bf2f(sw[d + 32]);
        cs64[k] = *(const f32x4*)((const float*)(ws + WS_ROPE64) + ((size_t)pos * 64 + 2 * i) * 2);
        cs32[k] = *(const f32x2*)((const float*)(ws + WS_ROPE32) + ((size_t)pos * 32 + d) * 2); }
#pragma unroll
    for (int k = 0; k < NB; ++k) {
        const int t = tk[k];
        {
            float x0 = bflo(u0[k]), x1 = bfhi(u0[k]), y0 = bflo(u1[k]), y1 = bfhi(u1[k]);
            float ss = x0 * x0 + x1 * x1 + y0 * y0 + y1 * y1;
#pragma unroll
            for (int o = 1; o < 32; o <<= 1) ss += __shfl_xor(ss, o);
            const float rstd = rsqrtf(ss * (1.f / 128.f) + EPS);
            x0 *= rstd * ga.x; x1 *= rstd * ga.y; y0 *= rstd * gb.x; y1 *= rstd * gb.y;
            const f32x4 cs = cs64[k];
            const float ox0 = x0 * cs.x - y0 * cs.y, oy0 = y0 * cs.x + x0 * cs.y, ox1 = x1 * cs.z - y1 * cs.w, oy1 = y1 * cs.z + x1 * cs.w;
            unsigned char* d8 = ws + WS_K8 + (size_t)t * 256 + g * 128 + 2 * i;
            const int w0 = __builtin_amdgcn_cvt_pk_fp8_f32(ox0 * K8_SCALE, ox1 * K8_SCALE, 0, false), w1 = __builtin_amdgcn_cvt_pk_fp8_f32(oy0 * K8_SCALE, oy1 * K8_SCALE, 0, false);
            *(unsigned short*)d8 = (unsigned short)w0; *(unsigned short*)(d8 + 64) = (unsigned short)w1;
        }
        {
            float x = kx[k], y = ky[k];
            float ss = x * x + y * y;
#pragma unroll
            for (int o = 1; o < 32; o <<= 1) ss += __shfl_xor(ss, o);
            const float rstd = rsqrtf(ss * (1.f / 64.f) + EPS);
            x *= rstd * gi0; y *= rstd * gi1;
            const f32x2 cs = cs32[k];
            const float ox = x * cs.x - y * cs.y, oy = y * cs.x + x * cs.y;
            bf16_t* dst = (bf16_t*)(ws + WS_KIN) + (size_t)(t >> 4) * 1024 + ((d >> 3) & 3) * 128 + (t & 15) * 8 + (d & 7);
            if (lane < 32) { dst[0] = (bf16_t)f2bf(ox); dst[512] = (bf16_t)f2bf(oy); }
        }
    }
}
__device__ __forceinline__ void mkprep_token(const Params& p, int m, int lane) {
    unsigned char* ws = p.ws;
    const int hd = lane >> 4, e0 = (lane & 15) * 16;
    const bf16_t* src = (const bf16_t*)(ws + WS_MKV) + (size_t)m * 2048 + hd * 256 + e0;
    float v[16]; unpack8(*(const u32x4*)src, v); unpack8(*(const u32x4*)(src + 8), v + 8);
    float ss = 0.f;
#pragma unroll
    for (int j = 0; j < 16; ++j) ss += v[j] * v[j];
#pragma unroll
    for (int o = 1; o < 16; o <<= 1) ss += __shfl_xor(ss, o);
    const float rstd = rsqrtf(ss * (1.f / 256.f) + EPS);
#pragma unroll
    for (int j = 0; j < 16; ++j) v[j] *= rstd * ((const float*)(ws + WS_CONST))[C_MKN + e0 + j];
    bf16_t* dst = (bf16_t*)(ws + WS_MKN) + (size_t)m * 1024 + hd * 256 + e0;
    *(bf16x8*)dst = pack8(v); *(bf16x8*)(dst + 8) = pack8(v + 8);
}

constexpr int LRU_WLDS = 19456;
template <bool APPLY>
__device__ __forceinline__ void lru_item(const Params& p, LAS unsigned char* wlds, int item, int lane) {
    unsigned char* ws = p.ws;
    const int ck = item >> 4, nblk = item & 15, t0 = ck * 128, c0 = nblk * 64;
    const bool first = (ck & 31) == 0;
    const int row = lane & 15, grp = lane >> 4;
    const bf16_t* LX = (const bf16_t*)(ws + WS_LX);
#pragma unroll
    for (int i = 0; i < 17; ++i) { const int r = (lane >> 3) + 8 * i;
        if (r < 131) { u32x4 v = (u32x4){0u, 0u, 0u, 0u};
            if (!(first && r < 3)) v = *(const u32x4*)(LX + (size_t)(t0 - 3 + r) * 1024 + c0 + (lane & 7) * 8);
            *(LAS u32x4*)(wlds + r * 144 + (lane & 7) * 16) = v; } }
    LDS_WAIT();
    {
        const float w0 = ((const float*)(ws + WS_CONST))[C_CONVW + 0 * 1024 + c0 + lane], w1 = ((const float*)(ws + WS_CONST))[C_CONVW + 1 * 1024 + c0 + lane], w2 = ((const float*)(ws + WS_CONST))[C_CONVW + 2 * 1024 + c0 + lane], w3 = ((const float*)(ws + WS_CONST))[C_CONVW + 3 * 1024 + c0 + lane], cb = ((const float*)(ws + WS_CONST))[C_CONVB + c0 + lane];
        LAS bf16_t* col = (LAS bf16_t*)wlds + lane;
        float xa = bf2f(col[130 * 72]), xb = bf2f(col[129 * 72]), xcc = bf2f(col[128 * 72]);
#pragma unroll 8
        for (int t = 127; t >= 0; --t) { const float xd = bf2f(col[t * 72]);
            const float y = cb + w3 * xa + w2 * xb + w1 * xcc + w0 * xd;
            col[(t + 3) * 72] = (bf16_t)f2bf(y);
            xa = xb; xb = xcc; xcc = xd; }
    }
    LDS_WAIT();
    bf16x8 wa[4][2], wi[4][2];
    {
        const bf16_t* WA = (const bf16_t*)(ws + WS_WAT) + nblk * 4096; const bf16_t* WI = (const bf16_t*)(ws + WS_WIT) + nblk * 4096;
#pragma unroll
        for (int nt = 0; nt < 4; ++nt)
#pragma unroll
            for (int ks = 0; ks < 2; ++ks) { const int o = (16 * nt + row) * 64 + 32 * ks + 8 * grp; wa[nt][ks] = *(const bf16x8*)(WA + o); wi[nt][ks] = *(const bf16x8*)(WI + o); }
    }
    float ba[4], bi[4], sp[4], hc[4], atot[4];
#pragma unroll
    for (int nt = 0; nt < 4; ++nt) { const int d = c0 + 16 * nt + row; ba[nt] = ((const float*)(ws + WS_CONST))[C_LBA + d]; bi[nt] = ((const float*)(ws + WS_CONST))[C_LBI + d];
        sp[nt] = 8.0f * log1pf(__expf(-((const float*)(ws + WS_CONST))[C_LAM + d])); hc[nt] = 0.f; atot[nt] = 1.f; }
    if (APPLY) {
        const f32x2* SU = (const f32x2*)(ws + WS_LRUS);
        const int cb0 = ck & ~31;
        for (int j = cb0; j < ck; ++j) {
#pragma unroll
            for (int nt = 0; nt < 4; ++nt) { const f32x2 s = SU[(size_t)j * 1024 + c0 + 16 * nt + row]; hc[nt] = s.x * hc[nt] + s.y; } }
    }
    for (int mt = 0; mt < 8; ++mt) {
        const LAS unsigned char* arow = wlds + (16 * mt + 3 + row) * 144 + 16 * grp;
        const bf16x8 a0 = *(const LAS bf16x8*)arow, a1 = *(const LAS bf16x8*)(arow + 64);
#pragma unroll
        for (int nt = 0; nt < 4; ++nt) {
            f32x4 ca = (f32x4){0.f, 0.f, 0.f, 0.f}, ci = (f32x4){0.f, 0.f, 0.f, 0.f};
            ca = MFMA16(a0, wa[nt][0], ca); ca = MFMA16(a1, wa[nt][1], ca);
            ci = MFMA16(a0, wi[nt][0], ci); ci = MFMA16(a1, wi[nt][1], ci);
            LAS bf16_t* slot = (LAS bf16_t*)(wlds + (16 * mt + 3 + 4 * grp) * 144) + 16 * nt + row;
            float A = 1.f, U = 0.f, hl[4], ap[4];
#pragma unroll
            for (int reg = 0; reg < 4; ++reg) {
                const float r = sigmoidf_(ca[reg] + ba[nt]), ig = sigmoidf_(ci[reg] + bi[nt]);
                const float la = -r * sp[nt];
                const float a = __expf(la), mult = __builtin_amdgcn_sqrtf(fmaxf(1.0f - a * a, 0.f));
                const float u = mult * ig * bf2f(slot[reg * 72]);
                U = a * U + u; A *= a; hl[reg] = U; ap[reg] = A;
            }
            const float A0 = __shfl(A, row), U0 = __shfl(U, row), A1 = __shfl(A, 16 + row), U1 = __shfl(U, 16 + row);
            const float A2 = __shfl(A, 32 + row), U2 = __shfl(U, 32 + row), A3 = __shfl(A, 48 + row), U3 = __shfl(U, 48 + row);
            const float h0 = hc[nt], h1 = A0 * h0 + U0, h2 = A1 * h1 + U1, h3 = A2 * h2 + U2, h4 = A3 * h3 + U3;
            if (!APPLY) {
                const float hin = grp == 0 ? h0 : (grp == 1 ? h1 : (grp == 2 ? h2 : h3));
                const float pg = grp == 0 ? 1.f : (grp == 1 ? A0 : (grp == 2 ? A0 * A1 : A0 * A1 * A2));
                const float apre = atot[nt] * pg;
                unsigned* HA = (unsigned*)p.out;
                const unsigned ho = (unsigned)(t0 + 16 * mt + 4 * grp) * 1024u + (unsigned)(c0 + 16 * nt + row);
#pragma unroll
                for (int reg = 0; reg < 4; ++reg) HA[ho + 1024u * reg] = pk2(hl[reg] + ap[reg] * hin, apre * ap[reg]);
            }
            hc[nt] = h4; atot[nt] *= (A0 * A1) * (A2 * A3);
            if (APPLY) {
                const float hin = grp == 0 ? h0 : (grp == 1 ? h1 : (grp == 2 ? h2 : h3));
#pragma unroll
                for (int reg = 0; reg < 4; ++reg) slot[reg * 72] = (bf16_t)f2bf(hl[reg] + ap[reg] * hin);
            }
        }
    }
    if (!APPLY) {
        if (grp == 0) { f32x2* SU = (f32x2*)(ws + WS_LRUS);
#pragma unroll
            for (int nt = 0; nt < 4; ++nt) { f32x2 s; s.x = atot[nt]; s.y = hc[nt]; SU[(size_t)ck * 1024 + c0 + 16 * nt + row] = s; } }
    } else {
        LDS_WAIT();
        bf16_t* GG = (bf16_t*)(ws + WS_GG);
#pragma unroll 4
        for (int i = 0; i < 16; ++i) { const int r = (lane >> 3) + 8 * i;
            float hv[8], gv[8];
            unpack8(*(const LAS u32x4*)(wlds + (r + 3) * 144 + (lane & 7) * 16), hv);
            bf16_t* gp = GG + (size_t)(t0 + r) * 1024 + c0 + (lane & 7) * 8;
            unpack8(*(const u32x4*)gp, gv);
#pragma unroll
            for (int j = 0; j < 8; ++j) hv[j] *= gv[j];
            *(bf16x8*)gp = pack8(hv); }
    }
    LDS_WAIT();
}

__device__ __forceinline__ void lru_apply_item(const Params& p, int item, int lane) {
    unsigned char* ws = p.ws;
    const int ck = item >> 3, cq = item & 3, th = (item >> 2) & 1;
    const unsigned c = (unsigned)(cq * 256 + 4 * lane);
    float hin[4] = {0.f, 0.f, 0.f, 0.f};
    { const f32x4* SU = (const f32x4*)(ws + WS_LRUS);
      for (int j = ck & ~31; j < ck; ++j) { const f32x4 s0 = SU[((size_t)j * 1024 + c) >> 1], s1 = SU[(((size_t)j * 1024 + c) >> 1) + 1];
          hin[0] = s0.x * hin[0] + s0.y; hin[1] = s0.z * hin[1] + s0.w; hin[2] = s1.x * hin[2] + s1.y; hin[3] = s1.z * hin[3] + s1.w; } }
    const unsigned* HA = (const unsigned*)p.out; bf16_t* GG = (bf16_t*)(ws + WS_GG);
    const unsigned base = (unsigned)(ck * 128 + th * 64) * 1024u + c;
#pragma unroll 8
    for (int r = 0; r < 64; ++r) {
        const u32x4 ha = *(const u32x4*)(HA + base + 1024u * r); const u32x2 gg = *(const u32x2*)(GG + base + 1024u * r);
        const float y0 = (bflo(ha.x) + bfhi(ha.x) * hin[0]) * bflo(gg.x), y1 = (bflo(ha.y) + bfhi(ha.y) * hin[1]) * bfhi(gg.x);
        const float y2 = (bflo(ha.z) + bfhi(ha.z) * hin[2]) * bflo(gg.y), y3 = (bflo(ha.w) + bfhi(ha.w) * hin[3]) * bfhi(gg.y);
        u32x2 w; w.x = pk2(y0, y1); w.y = pk2(y2, y3);
        *(u32x2*)(GG + base + 1024u * r) = w;
    }
}

constexpr int SC_STRIDE = 4100;
constexpr int IDX_SC_BYTES = 8 * SC_STRIDE * 4;
constexpr int IDX_SEL_OFF = IDX_SC_BYTES;

__device__ __forceinline__ float wave_max(float v) {
#pragma unroll
    for (int o = 1; o < 64; o <<= 1) v = fmaxf(v, __shfl_xor(v, o));
    return v;
}
__device__ __forceinline__ float wave_min(float v) {
#pragma unroll
    for (int o = 1; o < 64; o <<= 1) v = fminf(v, __shfl_xor(v, o));
    return v;
}
__device__ __forceinline__ unsigned wave_excl_scan(unsigned v, int lane) {
    unsigned s = v;
#pragma unroll
    for (int o = 1; o < 64; o <<= 1) { const unsigned t = __shfl_up(s, o); if (lane >= o) s += t; }
    return s - v;
}

constexpr int SEL_CAP = 128, SEL_HIST_B = 1056, SEL_CAND_B = 1040, SEL_OUT_B = 528, SEL_WLDS = SEL_HIST_B + SEL_CAND_B + SEL_OUT_B;
__device__ __forceinline__ int sel_bin(float x, float lo, float scale) { int b = (int)((x - lo) * scale); b = b > 255 ? 255 : b; b = b < 0 ? 0 : b; return b; }
__device__ __forceinline__ unsigned lane_rank(unsigned long long mask) { return __builtin_amdgcn_mbcnt_hi((unsigned)(mask >> 32), __builtin_amdgcn_mbcnt_lo((unsigned)mask, 0u)); }
__device__ __forceinline__ void select_top256(LAS float* rowp, int n, bf16_t* out, LAS unsigned char* wl, int lane) {
    LAS unsigned* hist = (LAS unsigned*)wl; LAS u32x2* cand = (LAS u32x2*)(wl + SEL_HIST_B); LAS bf16_t* outl = (LAS bf16_t*)(wl + SEL_HIST_B + SEL_CAND_B);
    const int imax4 = (((n + 255) >> 8) + 3) & ~3;
    LAS float* myp = rowp + 4 * lane;
    for (int i = n >> 8; i < imax4; ++i) { f32x4 x = *(LAS f32x4*)(myp + 256 * i);
#pragma unroll
        for (int j = 0; j < 4; ++j) x[j] = (256 * i + 4 * lane + j) < n ? x[j] : -INFINITY;
        *(LAS f32x4*)(myp + 256 * i) = x; }
    float lmx, lmn;
    { const f32x4 x = *(LAS f32x4*)myp; lmx = fmaxf(fmaxf(x[0], x[1]), fmaxf(x[2], x[3])); lmn = fminf(fminf(x[0], x[1]), fminf(x[2], x[3])); }
    *(LAS u32x2*)(outl + 4 * lane) = (u32x2){0u, 0u};
    int need = 256, base = 0; unsigned m = 0, c0 = 0u, c1 = 0u;
#pragma unroll 1
    for (int round = 0; round < 6; ++round) {
        const float hi = wave_max(lmx), lo = wave_min(lmn);
        const float scale = (hi > lo) ? 255.0f / (hi - lo) : 0.f;
        *(LAS u32x4*)(hist + 4 * lane) = (u32x4){0u, 0u, 0u, 0u};
        LDS_WAIT();
#pragma unroll 1
        for (int i0 = 0; i0 < imax4; i0 += 4) {
            f32x4 x[4];
#pragma unroll
            for (int u = 0; u < 4; ++u) x[u] = *(LAS f32x4*)(myp + 256 * (i0 + u));
#pragma unroll
            for (int u = 0; u < 4; ++u)
#pragma unroll
                for (int j = 0; j < 4; ++j) { const int b = sel_bin(x[u][j], lo, scale); const int hb = (x[u][j] > -INFINITY) ? b : 256; __hip_atomic_fetch_add(hist + hb, 1u, __ATOMIC_RELAXED, __HIP_MEMORY_SCOPE_WORKGROUP); } }
        LDS_WAIT();
        const u32x4 h4 = *(const LAS u32x4*)(hist + 4 * lane);
        const unsigned c4 = h4.x + h4.y + h4.z + h4.w;
        unsigned suf = c4;
#pragma unroll
        for (int o = 1; o < 64; o <<= 1) { const unsigned t = __shfl_down(suf, o); suf += (lane + o < 64) ? t : 0u; }
        unsigned run = suf - c4; int fb = -1; unsigned fabove = 0, fm = 0;
        { const unsigned nd = (unsigned)need;
          if (run < nd && run + h4.w >= nd) { fb = 4 * lane + 3; fabove = run; fm = h4.w; } run += h4.w;
          if (run < nd && run + h4.z >= nd) { fb = 4 * lane + 2; fabove = run; fm = h4.z; } run += h4.z;
          if (run < nd && run + h4.y >= nd) { fb = 4 * lane + 1; fabove = run; fm = h4.y; } run += h4.y;
          if (run < nd && run + h4.x >= nd) { fb = 4 * lane + 0; fabove = run; fm = h4.x; } }
        const unsigned long long bal = __ballot(fb >= 0);
        const int src = __ffsll((long long)bal) - 1;
        const int bstar = __shfl(fb, src); const unsigned above = (unsigned)__shfl((int)fabove, src); m = (unsigned)__shfl((int)fm, src);
        unsigned s0 = 0u, s1 = 0u; c0 = 0u; c1 = 0u;
        float nmx = -INFINITY, nmn = INFINITY;
#pragma unroll 1
        for (int i0 = 0; i0 < imax4; i0 += 4) {
            f32x4 x[4];
#pragma unroll
            for (int u = 0; u < 4; ++u) x[u] = *(LAS f32x4*)(myp + 256 * (i0 + u));
            unsigned s16 = 0u, k16 = 0u;
#pragma unroll
            for (int u = 0; u < 4; ++u) {
#pragma unroll
                for (int j = 0; j < 4; ++j) { const float xv = x[u][j]; const int b = sel_bin(xv, lo, scale); const bool isc = xv > -INFINITY; const bool sel = isc && b > bstar, kp = isc && b == bstar;
                    s16 |= sel ? (1u << (4 * u + j)) : 0u; k16 |= kp ? (1u << (4 * u + j)) : 0u;
                    const float y = kp ? xv : -INFINITY; x[u][j] = y; nmx = fmaxf(nmx, y); nmn = fminf(nmn, kp ? y : INFINITY); }
                *(LAS f32x4*)(myp + 256 * (i0 + u)) = x[u]; }
            const unsigned sh = (unsigned)(4 * i0) & 31u;
            if (i0 < 8) { s0 |= s16 << sh; c0 |= k16 << sh; } else { s1 |= s16 << sh; c1 |= k16 << sh; }
        }
        {
            unsigned off = (unsigned)base + wave_excl_scan((unsigned)(__popc(s0) + __popc(s1)), lane);
            while (s0) { const int k = __ffs((int)s0) - 1; s0 &= s0 - 1u; outl[off++] = (bf16_t)(256 * (k >> 2) + 4 * lane + (k & 3)); }
            while (s1) { const int k = __ffs((int)s1) - 1; s1 &= s1 - 1u; outl[off++] = (bf16_t)(256 * (8 + (k >> 2)) + 4 * lane + (k & 3)); }
        }
        base += (int)above; need -= (int)above; lmx = nmx; lmn = nmn;
        if (m <= (unsigned)SEL_CAP) break;
        if (!(wave_max(nmx) > wave_min(nmn))) break;
    }
    {
        unsigned pos = wave_excl_scan((unsigned)(__popc(c0) + __popc(c1)), lane);
        while (c0) { const int k = __ffs((int)c0) - 1; c0 &= c0 - 1u; u32x2 c; c.x = __float_as_uint(myp[256 * (k >> 2) + (k & 3)]); c.y = (unsigned)(256 * (k >> 2) + 4 * lane + (k & 3));
            cand[pos < (unsigned)SEL_CAP ? pos : (unsigned)SEL_CAP] = c; ++pos; }
        while (c1) { const int k = __ffs((int)c1) - 1; c1 &= c1 - 1u; u32x2 c; c.x = __float_as_uint(myp[256 * (8 + (k >> 2)) + (k & 3)]); c.y = (unsigned)(256 * (8 + (k >> 2)) + 4 * lane + (k & 3));
            cand[pos < (unsigned)SEL_CAP ? pos : (unsigned)SEL_CAP] = c; ++pos; }
    }
    LDS_WAIT();
    if (m <= (unsigned)SEL_CAP) {
        for (unsigned ci = lane; ci < m; ci += 64) {
            const u32x2 my = cand[ci]; const float mv = __uint_as_float(my.x); int rank = 0;
            for (unsigned j = 0; j < m; ++j) { const u32x2 o = cand[j]; const float ov = __uint_as_float(o.x); rank += (ov > mv || (ov == mv && o.y < my.y)) ? 1 : 0; }
            if (rank < need) outl[base + rank] = (bf16_t)my.y;
        }
    } else {
        for (unsigned ci = lane; ci < (unsigned)SEL_CAP; ci += 64) if ((int)ci < need) outl[base + ci] = (bf16_t)cand[ci].y;
    }
    LDS_WAIT();
    *(u32x2*)(out + 4 * lane) = *(const LAS u32x2*)(outl + 4 * lane);
    LDS_WAIT();
}

static_assert(IDX_SEL_OFF + 8 * SEL_WLDS <= LDS_BYTES, "indexer LDS");
__device__ __forceinline__ float dpp_xor8_add(float x) {
    return x + __builtin_bit_cast(float, __builtin_amdgcn_update_dpp(0, __builtin_bit_cast(int, x), 0x128, 0xf, 0xf, true));
}
__device__ __forceinline__ void indexer_prefetch(const Params& p, int b, int p0, int lane, u32x4 (&qraw)[4][2], f32x4 (&cs)[4], float (&wraw)[4]) {
    unsigned char* ws = p.ws;
    const int q = lane & 7, hsel = (lane >> 3) & 1, grp = lane >> 4, tq = b * SEQ + p0 + q;
    const float* csp = (const float*)(ws + WS_ROPE32) + ((size_t)(p0 + q) * 32 + 8 * grp) * 2;
#pragma unroll
    for (int j4 = 0; j4 < 4; ++j4) cs[j4] = *(const f32x4*)(csp + 4 * j4);
#pragma unroll
    for (int hp = 0; hp < 4; ++hp) { const int head = 2 * hp + hsel;
        const bf16_t* src = (const bf16_t*)(ws + WS_QI) + (size_t)tq * 512 + head * 64 + 8 * grp;
        qraw[hp][0] = *(const u32x4*)src; qraw[hp][1] = *(const u32x4*)(src + 32);
        wraw[hp] = bf2f(((const bf16_t*)(ws + WS_KW))[(size_t)tq * 256 + 64 + head]); }
}
template <int MODE> __device__ __forceinline__ void indexer_phase(const Params& p, LAS unsigned char* lds, int bid, int G, int lane, int wave) {
    unsigned char* ws = p.ws;
    LAS float* SC = (LAS float*)lds;
    const int q = lane & 7, grp = lane >> 4, row = lane & 15;
    int pi2 = 2 * bid;
    if (pi2 >= 4096) return;
    u32x4 nqraw[4][2]; f32x4 ncs[4]; float nwraw[4];
    { const int pi = pi2 >> 1; indexer_prefetch(p, pi >> 8, (pi2 & 1) ? 8 * (511 - (pi & 255)) : 8 * (pi & 255), lane, nqraw, ncs, nwraw); }
#pragma unroll 1
    while (pi2 < 4096) {
        const int pi = pi2 >> 1, b = pi >> 8, pr = pi & 255, p0 = (pi2 & 1) ? 8 * (511 - pr) : 8 * pr, tq0 = b * SEQ + p0;
        const int nxt = pi2 + ((pi2 & 1) ? 2 * G - 1 : 1);
        bf16x8 bq[4][2]; float w[4];
        {
            float c[8], s[8];
#pragma unroll
            for (int j4 = 0; j4 < 4; ++j4) { const f32x4 t = ncs[j4]; c[2 * j4] = t.x; s[2 * j4] = t.y; c[2 * j4 + 1] = t.z; s[2 * j4 + 1] = t.w; }
#pragma unroll
            for (int hp = 0; hp < 4; ++hp) { float x0[8], x1[8], o0[8], o1[8]; unpack8(nqraw[hp][0], x0); unpack8(nqraw[hp][1], x1);
#pragma unroll
                for (int j = 0; j < 8; ++j) { o0[j] = (x0[j] * c[j] - x1[j] * s[j]) * 0.125f; o1[j] = (x1[j] * c[j] + x0[j] * s[j]) * 0.125f; }
                bq[hp][0] = pack8(o0); bq[hp][1] = pack8(o1); w[hp] = nwraw[hp] * 0.35355339059327373f; }
        }
        const int nkt = (p0 >> 4) + 1;
        const bf16_t* kbase = (const bf16_t*)(ws + WS_KIN) + (size_t)(b * SEQ) * 64 + grp * 128 + row * 8;
        bf16x8 n0[4], n1[4];
#define IDX_TLOAD(KT0) do { _Pragma("unroll") for (int u = 0; u < 4; ++u) { const int kt = (KT0) + 8 * u < nkt ? (KT0) + 8 * u : wave; const bf16_t* kp = kbase + (size_t)kt * 1024; \
            n0[u] = *(const bf16x8*)kp; n1[u] = *(const bf16x8*)(kp + 512); } } while (0)
        if (MODE != 2 && wave < nkt) IDX_TLOAD(wave);
        for (int kt0 = wave; MODE != 2 && kt0 < nkt; kt0 += 32) {
            bf16x8 a0[4], a1[4];
#pragma unroll
            for (int u = 0; u < 4; ++u) { a0[u] = n0[u]; a1[u] = n1[u]; }
            IDX_TLOAD(kt0 + 32);
#pragma unroll
            for (int u = 0; u < 4; ++u) {
                const int kt = kt0 + 8 * u;
                if (kt >= nkt) break;
                f32x4 acc = (f32x4){0.f, 0.f, 0.f, 0.f};
#pragma unroll
                for (int hp = 0; hp < 4; ++hp) { f32x4 c = (f32x4){0.f, 0.f, 0.f, 0.f}; c = MFMA16(a0[u], bq[hp][0], c); c = MFMA16(a1[u], bq[hp][1], c);
#pragma unroll
                    for (int r = 0; r < 4; ++r) acc[r] += fmaxf(c[r], 0.f) * w[hp]; }
#pragma unroll
                for (int r = 0; r < 4; ++r) { acc[r] = dpp_xor8_add(acc[r]); if (16 * kt + 4 * grp + r > p0 + q) acc[r] = -INFINITY; }
                if (row < 8 && kt < nkt) *(LAS f32x4*)(SC + q * SC_STRIDE + 16 * kt + 4 * grp) = acc;
            }
        }
#undef IDX_TLOAD
        __syncthreads();
        if (nxt < 4096) { const int npi = nxt >> 1; indexer_prefetch(p, npi >> 8, (nxt & 1) ? 8 * (511 - (npi & 255)) : 8 * (npi & 255), lane, nqraw, ncs, nwraw); }
        {
            const int pos = p0 + wave, n = pos + 1;
            bf16_t* out = (bf16_t*)(ws + WS_IDX) + (size_t)(tq0 + wave) * 256;
            if (MODE == 1) { }
            else if (n <= 256) { for (int i = lane; i < 256; i += 64) out[i] = (bf16_t)(i < n ? i : 0); }
            else select_top256(SC + wave * SC_STRIDE, n, out, lds + IDX_SEL_OFF + wave * SEL_WLDS, lane);
        }
        __syncthreads();
        pi2 = nxt;
    }
}

constexpr int ATT_RS = 288;
constexpr int ATT_KOFF = 32 * ATT_RS;
constexpr int ATT_WLDS = 64 * ATT_RS;
typedef short s16x4 __attribute__((ext_vector_type(4)));
__device__ __forceinline__ s16x4 lds_tr16(const LAS unsigned char* pp) { return __builtin_amdgcn_ds_read_tr16_b64_v4i16((LAS s16x4*)pp); }
template <int DRY> __device__ __forceinline__ void attn_item(const Params& p, LAS unsigned char* wlds, int tq, int g, int lane, const unsigned (&idx_in)[4], const u32x4 (&q_in)[4]) {
    unsigned char* ws = p.ws;
    const int b = tq >> 12, pos = tq & (SEQ - 1), cnt = pos + 1 < 256 ? pos + 1 : 256;
    const int row = lane & 15, grp = lane >> 4;
    bf16_t* Qrow = (bf16_t*)(ws + WS_Q) + (size_t)tq * 1024 + g * 512;
    unsigned idxr[4];
#pragma unroll
    for (int r = 0; r < 4; ++r) { idxr[r] = (64 * r + lane < cnt) ? idx_in[r] : 0u; if (DRY) idxr[r] &= (unsigned)(DRY - 1); }
    long qf8[4]; float sfix;
    {
        float qa[16], qb[16]; float ss = 0.f;
        unpack8(q_in[0], qa); unpack8(q_in[1], qa + 8); unpack8(q_in[2], qb); unpack8(q_in[3], qb + 8);
#pragma unroll
        for (int j = 0; j < 16; ++j) ss += qa[j] * qa[j] + qb[j] * qb[j];
        ss += __shfl_xor(ss, 16); ss += __shfl_xor(ss, 32);
        const float rstd = rsqrtf(ss * (1.f / 128.f) + EPS) * 0.08838834764831845f;
        const float* gn = ((const float*)(ws + WS_CONST)) + C_QN + 16 * grp;
        const float* cs = (const float*)(ws + WS_ROPE64) + ((size_t)pos * 64 + 16 * grp) * 2;
        float am = 0.f;
#pragma unroll
        for (int j4 = 0; j4 < 4; ++j4) { const f32x4 ga = *(const f32x4*)(gn + 4 * j4), gb = *(const f32x4*)(gn + 64 + 4 * j4); const f32x4 t0 = *(const f32x4*)(cs + 8 * j4), t1 = *(const f32x4*)(cs + 8 * j4 + 4);
            const float gav[4] = {ga.x, ga.y, ga.z, ga.w}, gbv[4] = {gb.x, gb.y, gb.z, gb.w}, cv[4] = {t0.x, t0.z, t1.x, t1.z}, sv[4] = {t0.y, t0.w, t1.y, t1.w};
#pragma unroll
            for (int u = 0; u < 4; ++u) { const int j = 4 * j4 + u; const float a = qa[j] * rstd * gav[u], bb = qb[j] * rstd * gbv[u];
                qa[j] = a * cv[u] - bb * sv[u]; qb[j] = bb * cv[u] + a * sv[u]; am = fmaxf(am, fmaxf(fabsf(qa[j]), fabsf(qb[j]))); } }
        am = fmaxf(am, __shfl_xor(am, 16)); am = fmaxf(am, __shfl_xor(am, 32));
        const float sc = am > 0.f ? 240.0f / am : 1.0f; sfix = (am > 0.f ? am * (1.0f / 240.0f) : 1.0f) * (1.4426950408889634f / K8_SCALE);
#pragma unroll
        for (int m = 0; m < 4; ++m) { const float* v = (m < 2 ? qa : qb) + 8 * (m & 1); int lo = 0, hi = 0;
            lo = __builtin_amdgcn_cvt_pk_fp8_f32(v[0] * sc, v[1] * sc, lo, false); lo = __builtin_amdgcn_cvt_pk_fp8_f32(v[2] * sc, v[3] * sc, lo, true);
            hi = __builtin_amdgcn_cvt_pk_fp8_f32(v[4] * sc, v[5] * sc, hi, false); hi = __builtin_amdgcn_cvt_pk_fp8_f32(v[6] * sc, v[7] * sc, hi, true);
            qf8[m] = (long)(((unsigned long long)(unsigned)hi << 32) | (unsigned long long)(unsigned)lo); }
    }
    f32x4 S[16];
    {
        const unsigned char* Kb = ws + WS_K8; const unsigned koff = (unsigned)b * (SEQ * 256u) + g * 128u + 16u * (lane & 7);
        LAS unsigned char* kst = wlds + ATT_KOFF + (lane >> 3) * 144 + 16 * (lane & 7);
        const LAS unsigned char* kfr = wlds + ATT_KOFF + row * 144 + 16 * grp;
        u32x4 kr[4][2];
#define ATT_KLOAD(BUF, KT) do { _Pragma("unroll") for (int i = 0; i < 2; ++i) { const int slot = 16 * (KT) + 8 * i; \
            const unsigned e = (unsigned)__shfl((int)idxr[slot >> 6], (slot & 63) + (lane >> 3)); kr[BUF][i] = *(const u32x4*)(Kb + (e * 256u + koff)); } } while (0)
        ATT_KLOAD(0, 0); ATT_KLOAD(1, 1); ATT_KLOAD(2, 2); ATT_KLOAD(3, 3);
#pragma unroll
        for (int kt = 0; kt < 16; ++kt) {
            const int buf = kt & 3;
#pragma unroll
            for (int i = 0; i < 2; ++i) *(LAS u32x4*)(kst + buf * (16 * 144) + 8 * i * 144) = kr[buf][i];
            if (kt + 4 < 16) ATT_KLOAD(buf, kt + 4);
            LDS_WAIT();
            const u32x4 r0 = *(const LAS u32x4*)(kfr + buf * (16 * 144)), r1 = *(const LAS u32x4*)(kfr + buf * (16 * 144) + 64);
            f32x4 acc = (f32x4){0.f, 0.f, 0.f, 0.f};
            acc = __builtin_amdgcn_mfma_f32_16x16x32_fp8_fp8((long)(((unsigned long long)r0.y << 32) | r0.x), qf8[0], acc, 0, 0, 0);
            acc = __builtin_amdgcn_mfma_f32_16x16x32_fp8_fp8((long)(((unsigned long long)r0.w << 32) | r0.z), qf8[1], acc, 0, 0, 0);
            acc = __builtin_amdgcn_mfma_f32_16x16x32_fp8_fp8((long)(((unsigned long long)r1.y << 32) | r1.x), qf8[2], acc, 0, 0, 0);
            acc = __builtin_amdgcn_mfma_f32_16x16x32_fp8_fp8((long)(((unsigned long long)r1.w << 32) | r1.z), qf8[3], acc, 0, 0, 0);
            S[kt] = acc * sfix;
            __builtin_amdgcn_sched_barrier(0);
        }
#undef ATT_KLOAD
    }
    bf16x8 pf[8]; float pinv;
    {
        if (cnt < 256) {
#pragma unroll
            for (int kt = 0; kt < 16; ++kt)
#pragma unroll
                for (int r = 0; r < 4; ++r) if (16 * kt + 4 * grp + r >= cnt) S[kt][r] = -INFINITY;
        }
        float mx = -INFINITY;
#pragma unroll
        for (int kt = 0; kt < 16; ++kt) mx = fmaxf(mx, fmaxf(fmaxf(S[kt][0], S[kt][1]), fmaxf(S[kt][2], S[kt][3])));
        mx = fmaxf(mx, __shfl_xor(mx, 16)); mx = fmaxf(mx, __shfl_xor(mx, 32));
        float sum = 0.f;
#pragma unroll
        for (int kt = 0; kt < 16; ++kt)
#pragma unroll
            for (int r = 0; r < 4; ++r) { const float ev = __builtin_amdgcn_exp2f(S[kt][r] - mx); S[kt][r] = ev; sum += ev; }
        sum += __shfl_xor(sum, 16); sum += __shfl_xor(sum, 32);
        pinv = frcp(sum);
#pragma unroll
        for (int ks = 0; ks < 8; ++ks) { float t[8];
#pragma unroll
            for (int r = 0; r < 4; ++r) { t[r] = S[2 * ks][r]; t[4 + r] = S[2 * ks + 1][r]; }
            pf[ks] = pack8(t); }
    }
    f32x4 O[8];
#pragma unroll
    for (int mt = 0; mt < 8; ++mt) O[mt] = (f32x4){0.f, 0.f, 0.f, 0.f};
    const unsigned char* Vb = ws + WS_V; const unsigned voff = (unsigned)b * (SEQ * 512u) + g * 256u + 16u * row;
    LAS unsigned char* wst = wlds + grp * ATT_RS + 16 * row;
    const LAS unsigned char* trp = wlds + (4 * grp + (row >> 2)) * ATT_RS + 8 * (row & 3);
    u32x4 vr[8];
#define ATT_VLOAD(RD) do { _Pragma("unroll") for (int i = 0; i < 8; ++i) { const int slot = 32 * (RD) + 4 * i; \
        const unsigned e = (unsigned)__shfl((int)idxr[slot >> 6], (slot & 63) + grp); vr[i] = *(const u32x4*)(Vb + (e * 512u + voff)); } } while (0)
    __builtin_amdgcn_sched_barrier(0);
    ATT_VLOAD(0);
#pragma unroll
    for (int rd = 0; rd < 8; ++rd) {
#pragma unroll
        for (int i = 0; i < 8; ++i) *(LAS u32x4*)(wst + 4 * i * ATT_RS) = vr[i];
        if (rd < 7) ATT_VLOAD(rd + 1);
        LDS_WAIT();
#pragma unroll
        for (int mt = 0; mt < 8; ++mt) {
            const s16x4 t0 = lds_tr16(trp + 32 * mt), t1 = lds_tr16(trp + 16 * ATT_RS + 32 * mt);
            const bf16x8 a = (bf16x8){t0[0], t0[1], t0[2], t0[3], t1[0], t1[1], t1[2], t1[3]};
            O[mt] = MFMA16(a, pf[rd], O[mt]);
        }
        LDS_WAIT();
    }
#undef ATT_VLOAD
    if (row < 4 && (!DRY || O[0][0] == 12345.678f)) {
        bf16_t* op = Qrow + row * 128 + 4 * grp;
#pragma unroll
        for (int mt = 0; mt < 8; ++mt) { u32x2 w; w.x = pk2(O[mt][0] * pinv, O[mt][1] * pinv); w.y = pk2(O[mt][2] * pinv, O[mt][3] * pinv); *(u32x2*)(op + 16 * mt) = w; }
    }
}
__device__ __forceinline__ void attn_prefetch(const Params& p, int tq, int g, int lane, unsigned (&idx_o)[4], u32x4 (&q_o)[4]) {
    const bf16_t* ip = (const bf16_t*)(p.ws + WS_IDX) + (size_t)tq * 256;
#pragma unroll
    for (int r = 0; r < 4; ++r) idx_o[r] = (unsigned)ip[64 * r + lane];
    const int row = lane & 15, grp = lane >> 4;
    const bf16_t* qp = (const bf16_t*)(p.ws + WS_Q) + (size_t)tq * 1024 + g * 512 + (row & 3) * 128 + 16 * grp;
    const u32x4 z = (u32x4){0u, 0u, 0u, 0u};
    const u32x4 a = *(const u32x4*)qp, b2 = *(const u32x4*)(qp + 8), c = *(const u32x4*)(qp + 64), d = *(const u32x4*)(qp + 72);
    q_o[0] = row < 4 ? a : z; q_o[1] = row < 4 ? b2 : z; q_o[2] = row < 4 ? c : z; q_o[3] = row < 4 ? d : z;
}
template <int DRY> __device__ __forceinline__ void attn_phase(const Params& p, LAS unsigned char* wlds, int nc, int cls, int cw, int ncw, int lane) {
    const int nbat = (NBATCH - cls + nc - 1) / nc, total = nbat * 2 * SEQ;
    if (cw >= total) return;
    unsigned nidx[4]; u32x4 nq[4];
    { const int f = cw; attn_prefetch(p, (cls + nc * (f >> 13)) * SEQ + (f & (SEQ - 1)), (f >> 12) & 1, lane, nidx, nq); }
    for (int f = cw; f < total; f += ncw) {
        unsigned cidx[4]; u32x4 cq[4];
#pragma unroll
        for (int r = 0; r < 4; ++r) { cidx[r] = nidx[r]; cq[r] = nq[r]; }
        const int fn = f + ncw < total ? f + ncw : f;
        attn_prefetch(p, (cls + nc * (fn >> 13)) * SEQ + (fn & (SEQ - 1)), (fn >> 12) & 1, lane, nidx, nq);
        attn_item<DRY>(p, wlds, (cls + nc * (f >> 13)) * SEQ + (f & (SEQ - 1)), (f >> 12) & 1, lane, cidx, cq);
    }
}

constexpr int MEM_CS = 528;
constexpr int MEM_CHUNK = 32 * MEM_CS;
constexpr int MEM_POFF = 2 * MEM_CHUNK;
constexpr int MEM_PW = 16 * 528;
static_assert(MEM_POFF + 8 * MEM_PW <= LDS_BYTES, "memattn LDS");
__device__ __forceinline__ void memattn_block(const Params& p, LAS unsigned char* lds, int item, int lane, int wave) {
    unsigned char* ws = p.ws;
    const int tile = item >> 2, hm = item & 3, t0 = tile * 128 + wave * 16, b = (tile * 128) >> 12;
    const int row = lane & 15, grp = lane >> 4;
    bf16_t* MQ = (bf16_t*)(ws + WS_MQ);
    bf16x8 af[8];
    {
        float ss = 0.f;
        const bf16_t* src = MQ + (size_t)(t0 + row) * 1024 + hm * 256 + 8 * grp;
#pragma unroll
        for (int ks = 0; ks < 8; ++ks) { float qv[8]; unpack8(*(const u32x4*)(src + 32 * ks), qv);
#pragma unroll
            for (int j = 0; j < 8; ++j) ss += qv[j] * qv[j]; }
        ss += __shfl_xor(ss, 16); ss += __shfl_xor(ss, 32);
        const float rstd = rsqrtf(ss * (1.f / 256.f) + EPS) * 0.0625f;
        __builtin_amdgcn_sched_barrier(0);
#pragma unroll
        for (int ks = 0; ks < 8; ++ks) { float qv[8]; unpack8(*(const u32x4*)(src + 32 * ks), qv);
            const f32x4 g0 = *(const f32x4*)(((const float*)(ws + WS_CONST)) + C_MQN + 32 * ks + 8 * grp), g1 = *(const f32x4*)(((const float*)(ws + WS_CONST)) + C_MQN + 32 * ks + 8 * grp + 4);
            qv[0] *= rstd * g0.x; qv[1] *= rstd * g0.y; qv[2] *= rstd * g0.z; qv[3] *= rstd * g0.w;
            qv[4] *= rstd * g1.x; qv[5] *= rstd * g1.y; qv[6] *= rstd * g1.z; qv[7] *= rstd * g1.w;
            af[ks] = pack8(qv);
            if (ks & 1) __builtin_amdgcn_sched_barrier(0); }
    }
    const int tid = wave * 64 + lane;
    const unsigned char* MKg = ws + WS_MKN; const unsigned mkoff = ((unsigned)(b * 256) * 1024u + hm * 256u) * 2u;
    const unsigned char* MVg = ws + WS_MVT; const unsigned mvoff = (unsigned)(b * 4 + hm) * 131072u;
    const int cr0 = tid >> 5, cc = tid & 31;
    LAS unsigned char* cst = lds + cr0 * MEM_CS + 16 * cc;
    const LAS unsigned char* cfr = lds + row * MEM_CS + 16 * grp;
    u32x4 cg[2];
#define MEM_CLOAD(C) do { if ((C) < 8) { _Pragma("unroll") for (int j = 0; j < 2; ++j) cg[j] = *(const u32x4*)(MKg + (mkoff + (unsigned)(32 * (C) + cr0 + 16 * j) * 2048u + 16u * cc)); } \
        else { _Pragma("unroll") for (int j = 0; j < 2; ++j) cg[j] = *(const u32x4*)(MVg + (mvoff + (unsigned)(32 * ((C) - 8) + cr0 + 16 * j) * 512u + 16u * cc)); } } while (0)
#define MEM_CSTORE(BUF) do { _Pragma("unroll") for (int j = 0; j < 2; ++j) *(LAS u32x4*)(cst + (BUF) * MEM_CHUNK + 16 * j * MEM_CS) = cg[j]; } while (0)
    MEM_CLOAD(0); MEM_CSTORE(0);
    __syncthreads();
    f32x4 S[16];
#pragma unroll
    for (int c = 0; c < 8; ++c) {
        MEM_CLOAD(c + 1);
#pragma unroll
        for (int n2 = 0; n2 < 2; ++n2) { f32x4 acc = (f32x4){0.f, 0.f, 0.f, 0.f};
#pragma unroll
            for (int ks = 0; ks < 8; ++ks) acc = MFMA16(af[ks], *(const LAS bf16x8*)(cfr + (c & 1) * MEM_CHUNK + 16 * n2 * MEM_CS + 64 * ks), acc);
            S[2 * c + n2] = acc; }
        MEM_CSTORE((c + 1) & 1);
        __syncthreads();
    }
#pragma unroll
    for (int r = 0; r < 4; ++r) {
        float mx = -INFINITY;
#pragma unroll
        for (int nt = 0; nt < 16; ++nt) mx = fmaxf(mx, S[nt][r]);
#pragma unroll
        for (int o = 1; o < 16; o <<= 1) mx = fmaxf(mx, __shfl_xor(mx, o));
        float sum = 0.f;
#pragma unroll
        for (int nt = 0; nt < 16; ++nt) { const float e = __expf(S[nt][r] - mx); S[nt][r] = e; sum += e; }
#pragma unroll
        for (int o = 1; o < 16; o <<= 1) sum += __shfl_xor(sum, o);
        const float inv = frcp(sum);
#pragma unroll
        for (int nt = 0; nt < 16; ++nt) S[nt][r] *= inv;
    }
    LAS unsigned char* pw = lds + MEM_POFF + wave * MEM_PW;
#pragma unroll
    for (int nt = 0; nt < 16; ++nt)
#pragma unroll
        for (int r = 0; r < 4; ++r) *(LAS bf16_t*)(pw + (4 * grp + r) * 528 + (16 * nt + row) * 2) = (bf16_t)f2bf(S[nt][r]);
    LDS_WAIT();
    bf16x8 pf[8];
#pragma unroll
    for (int ks = 0; ks < 8; ++ks) pf[ks] = *(const LAS bf16x8*)(pw + row * 528 + (32 * ks + 8 * grp) * 2);
    const unsigned ooff = (unsigned)(t0 + 4 * grp) * 1024u + hm * 256u + row;
#pragma unroll
    for (int c = 8; c < 16; ++c) {
        if (c + 1 < 16) MEM_CLOAD(c + 1);
#pragma unroll
        for (int n2 = 0; n2 < 2; ++n2) { f32x4 acc = (f32x4){0.f, 0.f, 0.f, 0.f};
#pragma unroll
            for (int ks = 0; ks < 8; ++ks) acc = MFMA16(pf[ks], *(const LAS bf16x8*)(cfr + (c & 1) * MEM_CHUNK + 16 * n2 * MEM_CS + 64 * ks), acc);
#pragma unroll
            for (int r = 0; r < 4; ++r) MQ[ooff + (unsigned)(r * 1024 + 16 * (2 * (c - 8) + n2))] = (bf16_t)f2bf(acc[r]); }
        if (c + 1 < 16) MEM_CSTORE((c + 1) & 1);
        __syncthreads();
    }
#undef MEM_CLOAD
#undef MEM_CSTORE
}

#define CE_DESC(a, b) do { const unsigned _mx = (a) > (b) ? (a) : (b); const unsigned _mn = (a) > (b) ? (b) : (a); (a) = _mx; (b) = _mn; } while (0)
__device__ __forceinline__ void sort16_desc(unsigned (&a)[16]) {
#pragma unroll
    for (int k = 2; k <= 16; k <<= 1)
#pragma unroll
        for (int j = k >> 1; j > 0; j >>= 1)
#pragma unroll
            for (int i = 0; i < 16; ++i) { const int l = i ^ j; if (l > i) { if ((i & k) == 0) CE_DESC(a[i], a[l]); else CE_DESC(a[l], a[i]); } }
}
__device__ __forceinline__ void merge_top16(unsigned (&a)[16], const unsigned (&b)[16]) {
#pragma unroll
    for (int i = 0; i < 16; ++i) a[i] = a[i] > b[15 - i] ? a[i] : b[15 - i];
#pragma unroll
    for (int j = 8; j > 0; j >>= 1)
#pragma unroll
        for (int i = 0; i < 16; ++i) { const int l = i ^ j; if (l > i) CE_DESC(a[i], a[l]); }
}
__device__ __forceinline__ unsigned f2sortable(float f) { const unsigned u = __float_as_uint(f); return u ^ (((unsigned)((int)u >> 31)) | 0x80000000u); }
__device__ __forceinline__ float sortable2f(unsigned s) { const unsigned u = (s & 0x80000000u) ? (s ^ 0x80000000u) : ~s; return __uint_as_float(u); }

constexpr int PEER_WLDS = 64 * 32;
constexpr int PR_RS = 288, PR_SK_BYTES = 256 * PR_RS;
__device__ __forceinline__ void peer_route_item(const Params& p, const LAS unsigned char* skl, LAS unsigned char* wlds, int tt, int h, int lane) {
    unsigned char* ws = p.ws;
    const int t0 = tt * 16;
    const int row = lane & 15, grp = lane >> 4;
    unsigned top[2][16];
#pragma unroll
    for (int ph = 0; ph < 2; ++ph) {
        const int hp = h * 2 + ph;
        bf16x8 bf[4];
        { const bf16_t* qp = (const bf16_t*)(ws + WS_PQ) + (size_t)(t0 + row) * 2048 + hp * 128 + 8 * grp;
#pragma unroll
          for (int ks = 0; ks < 4; ++ks) bf[ks] = *(const bf16x8*)(qp + 32 * ks); }
        const LAS unsigned char* sk = skl + ph * (128 * PR_RS) + row * PR_RS + 16 * grp;
        unsigned keys[32];
#pragma unroll
        for (int mt = 0; mt < 8; ++mt) { f32x4 acc = (f32x4){0.f, 0.f, 0.f, 0.f}; const LAS unsigned char* ap = sk + 16 * mt * PR_RS;
#pragma unroll
            for (int ks = 0; ks < 4; ++ks) acc = MFMA16(*(const LAS bf16x8*)(ap + 64 * ks), bf[ks], acc);
#pragma unroll
            for (int r = 0; r < 4; ++r) { const int key = 16 * mt + 4 * grp + r; keys[4 * mt + r] = (f2sortable(acc[r]) & 0xFFFFFF80u) | (unsigned)(127 - key); } }
        unsigned a[16], bb[16];
#pragma unroll
        for (int i = 0; i < 16; ++i) { a[i] = keys[i]; bb[i] = keys[16 + i]; }
        sort16_desc(a); sort16_desc(bb); merge_top16(a, bb);
#pragma unroll
        for (int i = 0; i < 16; ++i) bb[i] = (unsigned)__shfl_xor((int)a[i], 16);
        merge_top16(a, bb);
#pragma unroll
        for (int i = 0; i < 16; ++i) bb[i] = (unsigned)__shfl_xor((int)a[i], 32);
        merge_top16(a, bb);
#pragma unroll
        for (int i = 0; i < 16; ++i) top[ph][i] = a[i];
    }
    LAS unsigned* myb = (LAS unsigned*)(wlds + lane * 32);
#pragma unroll
    for (int ph = 0; ph < 2; ++ph)
#pragma unroll
        for (int w4 = 0; w4 < 4; ++w4) { unsigned pk = 0u;
#pragma unroll
            for (int j = 0; j < 4; ++j) pk |= (127u - (top[ph][4 * w4 + j] & 0x7Fu)) << (8 * j);
            myb[ph * 4 + w4] = pk; }
    float v1[16], v2[16];
#pragma unroll
    for (int i = 0; i < 16; ++i) { v1[i] = sortable2f(top[0][i] & 0xFFFFFF80u); v2[i] = sortable2f(top[1][i] & 0xFFFFFF80u); }
    unsigned c[4][16];
    {
        int ci = 0;
#pragma unroll
        for (int r1 = 0; r1 < 16; ++r1)
#pragma unroll
            for (int r2 = 0; r2 < 16; ++r2) if ((r1 + 1) * (r2 + 1) <= 16) { c[ci >> 4][ci & 15] = (f2sortable(v1[r1] + v2[r2]) & 0xFFFFFF00u) | (unsigned)(255 - (r1 * 16 + r2)); ++ci; }
#pragma unroll
        for (int z = 50; z < 64; ++z) c[z >> 4][z & 15] = 0u;
    }
    sort16_desc(c[0]); sort16_desc(c[1]); sort16_desc(c[2]); sort16_desc(c[3]);
    merge_top16(c[0], c[1]); merge_top16(c[2], c[3]); merge_top16(c[0], c[2]);
    float gsc[16]; float sum = 0.f; const float vmax = sortable2f(c[0][0] & 0xFFFFFF00u);
#pragma unroll
    for (int i = 0; i < 16; ++i) { gsc[i] = __expf(sortable2f(c[0][i] & 0xFFFFFF00u) - vmax); sum += gsc[i]; }
    const float inv = 1.0f / sum;
    LDS_WAIT();
    int eid[16];
    const LAS unsigned char* mybb = (const LAS unsigned char*)(wlds + lane * 32);
#pragma unroll
    for (int i = 0; i < 16; ++i) { const unsigned flat = 255u - (c[0][i] & 0xFFu); const int i1 = mybb[flat >> 4], i2 = mybb[16 + (flat & 15u)]; eid[i] = i1 * 128 + i2; gsc[i] *= inv; }
    int* eo = (int*)(ws + WS_EIDX) + (size_t)(t0 + row) * 128 + h * 16; float* go = (float*)(ws + WS_EG) + (size_t)(t0 + row) * 128 + h * 16;
    typedef int i32x4 __attribute__((ext_vector_type(4)));
    if (grp == 0) { *(i32x4*)(eo + 0) = (i32x4){eid[0], eid[1], eid[2], eid[3]}; *(f32x4*)(go + 0) = (f32x4){gsc[0], gsc[1], gsc[2], gsc[3]}; }
    else if (grp == 1) { *(i32x4*)(eo + 4) = (i32x4){eid[4], eid[5], eid[6], eid[7]}; *(f32x4*)(go + 4) = (f32x4){gsc[4], gsc[5], gsc[6], gsc[7]}; }
    else if (grp == 2) { *(i32x4*)(eo + 8) = (i32x4){eid[8], eid[9], eid[10], eid[11]}; *(f32x4*)(go + 8) = (f32x4){gsc[8], gsc[9], gsc[10], gsc[11]}; }
    else { *(i32x4*)(eo + 12) = (i32x4){eid[12], eid[13], eid[14], eid[15]}; *(f32x4*)(go + 12) = (f32x4){gsc[12], gsc[13], gsc[14], gsc[15]}; }
    LDS_WAIT();
}

__device__ __forceinline__ void peer_route_phase(const Params& p, LAS unsigned char* lds, int bid, int G, int wave, int lane) {
    const bool split = (G & 7) == 0;
    const int hstart = split ? (bid & 7) : 0, hstep = split ? 8 : 1, trank = split ? (bid >> 3) : bid, tstride = split ? (G >> 3) : G;
    const int tid = wave * 64 + lane;
    for (int h = hstart; h < 8; h += hstep) {
        __syncthreads();
        const unsigned char* src = p.ws + WS_SUBK + (size_t)h * 65536;
#pragma unroll
        for (int j = 0; j < 8; ++j) { const int q = tid + 512 * j, r = q >> 4, c = q & 15; *(LAS u32x4*)(lds + r * PR_RS + 16 * c) = *(const u32x4*)(src + (size_t)r * 256 + 16 * c); }
        __syncthreads();
        for (int tt = trank * NWAVES + wave; tt < T_TOK / 16; tt += tstride * NWAVES) peer_route_item(p, lds, lds + PR_SK_BYTES + wave * PEER_WLDS, tt, h, lane);
    }
}

__device__ __forceinline__ void quant_row_fp8(const float* src, unsigned char* dst, float* inv, int lane) {
    const f32x4* s4 = (const f32x4*)src + 4 * lane;
    f32x4 v[4]; float am = 0.f;
#pragma unroll
    for (int j = 0; j < 4; ++j) { v[j] = s4[j]; am = fmaxf(am, fmaxf(fmaxf(fabsf(v[j].x), fabsf(v[j].y)), fmaxf(fabsf(v[j].z), fabsf(v[j].w)))); }
    am = wave_max(am);
    const float sc = am > 0.f ? 240.0f / am : 1.0f;
    u32x4 o;
#pragma unroll
    for (int j = 0; j < 4; ++j) { int w = 0; w = __builtin_amdgcn_cvt_pk_fp8_f32(v[j].x * sc, v[j].y * sc, w, false); w = __builtin_amdgcn_cvt_pk_fp8_f32(v[j].z * sc, v[j].w * sc, w, true); o[j] = (unsigned)w; }
    *(u32x4*)(dst + (size_t)(lane >> 3) * 2097152 + 16 * (lane & 7)) = o;
    if (lane == 0) *inv = am > 0.f ? am / 240.0f : 1.0f;
}
__device__ __forceinline__ void fp8x4_to_bf16x4(unsigned w, unsigned& lo, unsigned& hi) {
    const f32x2 a = __builtin_amdgcn_cvt_pk_f32_fp8((int)w, false), b = __builtin_amdgcn_cvt_pk_f32_fp8((int)w, true);
    lo = (__float_as_uint(a.x) >> 16) | (__float_as_uint(a.y) & 0xffff0000u);
    hi = (__float_as_uint(b.x) >> 16) | (__float_as_uint(b.y) & 0xffff0000u);
}
constexpr size_t WS_U8 = WS_UB, WS_V8 = WS_UB + 16 * MiB, WS_UVINV = WS_UB + 32 * MiB;
constexpr size_t WS_ZP = WS_PQ;
constexpr size_t WS_ACT = WS_KR;
constexpr int PZ_RS = 144, PZ_LIST = 128 * PZ_RS, PZ_WLDS = PZ_LIST + 1024;
template <int EMASK> __device__ __forceinline__ void peer_zpart_class(const Params& p, LAS unsigned char* wlds, int x, int cw, int ncw, int lane) {
    unsigned char* ws = p.ws;
    const int row = lane & 15, grp = lane >> 4, q = lane >> 3;
    const int* EI = (const int*)(ws + WS_EIDX);
    const unsigned char* U8 = ws + WS_U8; const unsigned uoff = 2097152u * x + 16u * (lane & 7);
    const bf16_t* XNb = (const bf16_t*)(ws + WS_XN) + 128 * x + 16 * grp;
    bf16_t* ZPb = (bf16_t*)(ws + WS_ZP) + (size_t)x * T_TOK * 128 + 4 * grp;
    if (cw >= T_TOK) return;
    typedef int i32x4 __attribute__((ext_vector_type(4)));
    LAS unsigned char* wst = wlds + (16 * q) * PZ_RS + 16 * (lane & 7);
    const LAS unsigned char* frd = wlds + row * PZ_RS + 16 * grp;
    int en[2]; u32x4 raw[16]; bf16x8 xb[4], xn[4];
#define PZ_GATHER(EV, LB) do { LAS int* lst = (LAS int*)(wlds + PZ_LIST + 512 * (LB)); lst[lane] = (EV)[0]; lst[64 + lane] = (EV)[1]; LDS_WAIT(); \
        _Pragma("unroll") for (int i4 = 0; i4 < 4; ++i4) { const i32x4 ev = *(const LAS i32x4*)(lst + 16 * q + 4 * i4); \
            raw[4 * i4 + 0] = *(const u32x4*)(U8 + ((unsigned)(ev.x & EMASK) * 128u + uoff)); raw[4 * i4 + 1] = *(const u32x4*)(U8 + ((unsigned)(ev.y & EMASK) * 128u + uoff)); \
            raw[4 * i4 + 2] = *(const u32x4*)(U8 + ((unsigned)(ev.z & EMASK) * 128u + uoff)); raw[4 * i4 + 3] = *(const u32x4*)(U8 + ((unsigned)(ev.w & EMASK) * 128u + uoff)); } } while (0)
    { const unsigned o = (unsigned)cw * 128u + lane; en[0] = EI[o]; en[1] = EI[o + 64u];
      const bf16_t* XN = XNb + (size_t)cw * 1024; xn[0] = *(const bf16x8*)XN; xn[1] = *(const bf16x8*)(XN + 8); xn[2] = *(const bf16x8*)(XN + 64); xn[3] = *(const bf16x8*)(XN + 72); }
    PZ_GATHER(en, 0);
    { const int t1 = cw + ncw < T_TOK ? cw + ncw : cw; const unsigned o1 = (unsigned)t1 * 128u + lane; en[0] = EI[o1]; en[1] = EI[o1 + 64u]; }
    int lb = 1;
    for (int t = cw; t < T_TOK; t += ncw) {
        bf16_t* zp = ZPb + (size_t)t * 128;
#pragma unroll
        for (int i = 0; i < 16; ++i) *(LAS u32x4*)(wst + i * PZ_RS) = raw[i];
#pragma unroll
        for (int i = 0; i < 4; ++i) xb[i] = xn[i];
        PZ_GATHER(en, lb);
        lb ^= 1;
        { const int t2 = t + 2 * ncw < T_TOK ? t + 2 * ncw : cw; const unsigned o2 = (unsigned)t2 * 128u + lane; en[0] = EI[o2]; en[1] = EI[o2 + 64u];
          const int t1 = t + ncw < T_TOK ? t + ncw : cw; const bf16_t* XN = XNb + (size_t)t1 * 1024; xn[0] = *(const bf16x8*)XN; xn[1] = *(const bf16x8*)(XN + 8); xn[2] = *(const bf16x8*)(XN + 64); xn[3] = *(const bf16x8*)(XN + 72); }
        long xq[4]; float xinv;
        {
            float xf[4][8]; float am = 0.f;
#pragma unroll
            for (int i = 0; i < 4; ++i) { unpack8(__builtin_bit_cast(u32x4, xb[i]), xf[i]);
#pragma unroll
                for (int j = 0; j < 8; ++j) am = fmaxf(am, fabsf(xf[i][j])); }
            am = fmaxf(am, __shfl_xor(am, 16)); am = fmaxf(am, __shfl_xor(am, 32));
            const float sc = am > 0.f ? 240.0f / am : 1.0f; xinv = am > 0.f ? am * (1.0f / 240.0f) : 1.0f;
#pragma unroll
            for (int i = 0; i < 4; ++i) { int lo = 0, hi = 0;
                lo = __builtin_amdgcn_cvt_pk_fp8_f32(xf[i][0] * sc, xf[i][1] * sc, lo, false); lo = __builtin_amdgcn_cvt_pk_fp8_f32(xf[i][2] * sc, xf[i][3] * sc, lo, true);
                hi = __builtin_amdgcn_cvt_pk_fp8_f32(xf[i][4] * sc, xf[i][5] * sc, hi, false); hi = __builtin_amdgcn_cvt_pk_fp8_f32(xf[i][6] * sc, xf[i][7] * sc, hi, true);
                xq[i] = (long)(((unsigned long long)(unsigned)hi << 32) | (unsigned long long)(unsigned)lo); }
        }
#pragma unroll
        for (int et = 0; et < 8; ++et) {
            const u32x4 r0 = *(const LAS u32x4*)(frd + 16 * et * PZ_RS), r1 = *(const LAS u32x4*)(frd + 16 * et * PZ_RS + 64);
            const long a0 = (long)(((unsigned long long)r0.y << 32) | r0.x), a1 = (long)(((unsigned long long)r0.w << 32) | r0.z);
            const long a2 = (long)(((unsigned long long)r1.y << 32) | r1.x), a3 = (long)(((unsigned long long)r1.w << 32) | r1.z);
            f32x4 acc = (f32x4){0.f, 0.f, 0.f, 0.f};
            acc = __builtin_amdgcn_mfma_f32_16x16x32_fp8_fp8(a0, xq[0], acc, 0, 0, 0); acc = __builtin_amdgcn_mfma_f32_16x16x32_fp8_fp8(a1, xq[1], acc, 0, 0, 0);
            acc = __builtin_amdgcn_mfma_f32_16x16x32_fp8_fp8(a2, xq[2], acc, 0, 0, 0); acc = __builtin_amdgcn_mfma_f32_16x16x32_fp8_fp8(a3, xq[3], acc, 0, 0, 0);
            if (row == 0) { u32x2 w; w.x = pk2(acc[0] * xinv, acc[1] * xinv); w.y = pk2(acc[2] * xinv, acc[3] * xinv); *(u32x2*)(zp + 16 * et) = w; }
        }
        LDS_WAIT();
    }
#undef PZ_GATHER
}
__device__ __forceinline__ void peer_act_token(const Params& p, int t, int lane) {
    unsigned char* ws = p.ws;
    const bf16_t* zp = (const bf16_t*)(ws + WS_ZP) + (size_t)t * 128;
    const int* eidp = (const int*)(ws + WS_EIDX) + (size_t)t * 128; const float* egp = (const float*)(ws + WS_EG) + (size_t)t * 128;
    const f32x2* UVINV = (const f32x2*)(ws + WS_UVINV);
    float* ap = (float*)(ws + WS_ACT) + (size_t)t * 128;
#pragma unroll
    for (int r = 0; r < 2; ++r) { const int s = 64 * r + lane; float z = 0.f;
#pragma unroll
        for (int x = 0; x < 8; ++x) z += bf2f(zp[(size_t)x * T_TOK * 128 + s]);
        const f32x2 iv = UVINV[eidp[s]];
        ap[s] = gelu_tanh(z * iv.x) * egp[s] * iv.y; }
}
constexpr int PO_WLDS = 1024 + 4096;
__device__ __forceinline__ void peer_out_class(const Params& p, LAS unsigned char* wlds, int x, int cw, int ncw, int lane) {
    unsigned char* ws = p.ws;
    const int* EI = (const int*)(ws + WS_EIDX); const float* AC = (const float*)(ws + WS_ACT);
    const unsigned char* V8 = ws + WS_V8; const unsigned voff = 2097152u * x + 16u * (lane & 7);
    if (cw >= T_TOK) return;
    typedef int i32x4 __attribute__((ext_vector_type(4)));
    LAS int* lei = (LAS int*)wlds; LAS float* lac = (LAS float*)(wlds + 512); LAS float* lps = (LAS float*)(wlds + 1024);
    const int q = lane >> 3, c = lane & 7;
    int en[2]; float an[2];
    { const unsigned o0 = (unsigned)cw * 128u + lane; en[0] = EI[o0]; en[1] = EI[o0 + 64u]; an[0] = AC[o0]; an[1] = AC[o0 + 64u]; }
    for (int t = cw; t < T_TOK; t += ncw) {
        lei[lane] = en[0]; lei[64 + lane] = en[1]; lac[lane] = an[0]; lac[64 + lane] = an[1];
        { const int t1 = t + ncw < T_TOK ? t + ncw : cw; const unsigned o1 = (unsigned)t1 * 128u + lane; en[0] = EI[o1]; en[1] = EI[o1 + 64u]; an[0] = AC[o1]; an[1] = AC[o1 + 64u]; }
        LDS_WAIT();
        int es[16]; float as[16];
#pragma unroll
        for (int i4 = 0; i4 < 4; ++i4) { const i32x4 ev = *(const LAS i32x4*)(lei + 16 * q + 4 * i4); const f32x4 av = *(const LAS f32x4*)(lac + 16 * q + 4 * i4);
            es[4 * i4] = ev.x; es[4 * i4 + 1] = ev.y; es[4 * i4 + 2] = ev.z; es[4 * i4 + 3] = ev.w; as[4 * i4] = av.x; as[4 * i4 + 1] = av.y; as[4 * i4 + 2] = av.z; as[4 * i4 + 3] = av.w; }
        u32x4 raw[16];
#pragma unroll
        for (int i = 0; i < 16; ++i) raw[i] = *(const u32x4*)(V8 + ((unsigned)es[i] * 128u + voff));
        float o[16];
#pragma unroll
        for (int j = 0; j < 16; ++j) o[j] = 0.f;
#pragma unroll
        for (int i = 0; i < 16; ++i) {
            const float av = as[i]; const u32x4 rw = raw[i];
#pragma unroll
            for (int w = 0; w < 4; ++w) { const f32x2 c0 = __builtin_amdgcn_cvt_pk_f32_fp8((int)rw[w], false), c1 = __builtin_amdgcn_cvt_pk_f32_fp8((int)rw[w], true);
                o[4 * w] += av * c0.x; o[4 * w + 1] += av * c0.y; o[4 * w + 2] += av * c1.x; o[4 * w + 3] += av * c1.y; }
            if (i & 1) __builtin_amdgcn_sched_barrier(0);
        }
#pragma unroll
        for (int w = 0; w < 4; ++w) *(LAS f32x4*)(lps + q * 128 + 16 * c + 4 * w) = (f32x4){o[4 * w], o[4 * w + 1], o[4 * w + 2], o[4 * w + 3]};
        LDS_WAIT();
        f32x2 s = *(const LAS f32x2*)(lps + 2 * lane);
#pragma unroll
        for (int k = 1; k < 8; ++k) { const f32x2 v = *(const LAS f32x2*)(lps + k * 128 + 2 * lane); s.x += v.x; s.y += v.y; }
        float* orow = p.out + (size_t)t * 1024 + 128 * x + 2 * lane;
        f32x2 xv = *(const f32x2*)orow; xv.x += s.x; xv.y += s.y; *(f32x2*)orow = xv;
        LDS_WAIT();
    }
}
#ifndef NOISEQ
#define NOISEQ 0
#endif

#ifndef STAGE
#define STAGE 99
#endif
template <int LAST, int SUB = 9> __global__ void __launch_bounds__(NTHREADS, 2) fwd_megakernel(Params p) {
    extern __shared__ __attribute__((aligned(16))) unsigned char lds_raw[];
    LAS unsigned char* lds = (LAS unsigned char*)lds_raw;
    const int wave = __builtin_amdgcn_readfirstlane((int)threadIdx.x >> 6); int lane = fresh_lane();
    const int G = gridDim.x, bid = blockIdx.x;
    const int gw = bid * NWAVES + wave, NGW = G * NWAVES;
    unsigned char* ws = p.ws;
    if (wave == 0 && lane < 4) ((LAS unsigned*)(lds + LDS_XB_OFF))[lane] = 0u;
    __syncthreads();
    const XcdBarrier xbar = xcd_barrier_post((unsigned*)(ws + WS_CTL), (volatile LAS unsigned*)(lds + LDS_XB_OFF), wave);
    if (wave == 0 && lane == 0) ((LAS unsigned*)(lds + LDS_XB_OFF))[2] = xb_add((unsigned*)(ws + WS_CTL) + 3584 + 64 * xbar.x, 1u);
#define GRID_SYNC() do { xcd_barrier(xbar, wave); lane = fresh_lane(); } while (0)

  {
    constexpr int last = LAST;
    phase_prologue(p, lds, lane, wave, gw, NGW);
    GRID_SYNC();
    int ncls, cls, crank, csize;
    {
        bool bal = (G & 7) == 0; int npop = 0, myidx = 0;
        for (int j = 0; j < 16; ++j) { const unsigned c = xb_ld((unsigned*)(ws + WS_CTL) + XB_XCNT(j)); bal = bal && (c == 0u || c == (unsigned)(G >> 3)); npop += c > 0u ? 1 : 0; myidx += (c > 0u && j < (int)xbar.x) ? 1 : 0; }
        bal = bal && npop == 8;
        const unsigned myrank = ((volatile LAS unsigned*)(lds + LDS_XB_OFF))[2];
        if (bal) { ncls = 8; cls = myidx; crank = (int)myrank; csize = G >> 3; }
        else { ncls = (G & 7) == 0 ? 8 : 1; cls = bid % ncls; crank = bid / ncls; csize = G / ncls; }
        ncls = __builtin_amdgcn_readfirstlane(ncls); cls = __builtin_amdgcn_readfirstlane(cls); crank = __builtin_amdgcn_readfirstlane(crank); csize = __builtin_amdgcn_readfirstlane(csize);
    }
    if constexpr (last < 1) return;

    {
        pg8::Gemm g{(const bf16_t*)(ws + WS_XN), (const bf16_t*)(ws + WS_W1T), T_TOK, N1F, 512}; pg8::StaticOrder S; S.init(T_TOK, N1F, G, bid);
        EpiRoute E{ws, 0, nullptr, 0, 0};
        pg8::gemm_phase<EpiRoute, pg8::StaticOrder, false, XW_E8M0>(lds, g, S, E, wave);
    }
    {
        pg8::Gemm g{(const bf16_t*)p.out, (const bf16_t*)(ws + WS_W1TB), T_TOK, N1B, 1024}; pg8::StaticOrder S; S.init(T_TOK, N1B, G, bid);
        EpiRoute E{ws, 0, nullptr, 0, N1F / 256};
        pg8::gemm_phase<EpiRoute, pg8::StaticOrder>(lds, g, S, E, wave);
    }
    {
        pg8::Gemm g{(const bf16_t*)(ws + WS_MN), (const bf16_t*)(ws + WS_WKVT), NBATCH * MEMT, 2048, 1024}; pg8::StaticOrder S; S.init(NBATCH * MEMT, 2048, G, (bid + G / 2) % G);
        EpiRoute E{ws, 1, (bf16_t*)(ws + WS_MKV), 2048, 0};
        pg8::gemm_phase<EpiRoute, pg8::StaticOrder>(lds, g, S, E, wave);
    }
    GRID_SYNC();

    if constexpr (last < 2) return;
    for (int t = gw; t < T_TOK; t += 4 * NGW) kprep_tokens<4>(p, t, NGW, lane);
    for (int m = gw; m < NBATCH * MEMT; m += NGW) mkprep_token(p, m, lane);
    {
        LAS float* scr = (LAS float*)(lds + wave * 16384);
        for (int it = gw; it < 1024; it += NGW) { const int bh = it >> 5, kb = (it >> 3) & 3, nb = it & 7, b = bh >> 2, hm = bh & 3;
            const bf16_t* src = (const bf16_t*)(ws + WS_MKV) + (size_t)(b * 256) * 2048 + 1024 + hm * 256;
            auto ld = [src](int k, int n) -> float { return bf2f(src[(size_t)k * 2048 + n]); };
            transpose_item(ld, (bf16_t*)(ws + WS_MVT) + (size_t)bh * 65536, 256, kb * 64, nb * 32, scr, lane); }
    }
    if constexpr (last == 2 && SUB == 0) return;
    __syncthreads(); lane = fresh_lane();
    for (int it = gw; it < 4096; it += NGW) lru_item<false>(p, lds + wave * LRU_WLDS, it, lane);
    GRID_SYNC();

    if constexpr (last < 3) return;
#ifdef IDRY
    indexer_phase<IDRY>(p, lds, bid, G, lane, wave);
    __syncthreads();
#endif
    indexer_phase<0>(p, lds, bid, G, lane, wave);
    if constexpr (last == 3 && SUB == 0) return;
    __syncthreads(); lane = fresh_lane();
    for (int it = gw; it < 2048; it += NGW) lru_apply_item(p, it, lane);
    if constexpr (last == 3 && SUB == 1) return;
    __syncthreads(); lane = fresh_lane();
    for (int it = bid; it < 1024; it += G) memattn_block(p, lds, it, lane, wave);
    GRID_SYNC();

    if constexpr (last < 4) return;
#ifdef ADRY
    attn_phase<ADRY>(p, lds + wave * ATT_WLDS, ncls, cls, crank * NWAVES + wave, csize * NWAVES, lane);
    __syncthreads();
#endif
    attn_phase<0>(p, lds + wave * ATT_WLDS, ncls, cls, crank * NWAVES + wave, csize * NWAVES, lane);
    GRID_SYNC();

    if constexpr (last < 5) return;
    {
        pg8::Gemm g{(const bf16_t*)(ws + WS_XN), (const bf16_t*)(ws + WS_WGT), T_TOK, NGATE, 512}; pg8::StaticOrder S; S.init(T_TOK, NGATE, G, bid);
        EpiMerge E{(const bf16_t*)(ws + WS_GG), (const bf16_t*)(ws + WS_Q), (const bf16_t*)(ws + WS_MQ), (bf16_t*)(ws + WS_MG)};
        pg8::gemm_phase<EpiMerge, pg8::StaticOrder, true, XW_E8M0>(lds, g, S, E, wave);
    }
    GRID_SYNC();

    if constexpr (last < 6) return;
    {
        pg8::Gemm g{(const bf16_t*)(ws + WS_MG), (const bf16_t*)(ws + WS_WOT), T_TOK, 1024, 1024}; pg8::StaticOrder S; S.init(T_TOK, 1024, G, bid);
        EpiOut E{p.x, p.out};
        pg8::gemm_phase<EpiOut, pg8::StaticOrder>(lds, g, S, E, wave);
    }
    for (int r = gw; r < 2 * 16384; r += NGW) { const int which = r >= 16384, rr = r & 16383;
        quant_row_fp8((which ? p.peer_v : p.peer_u) + (size_t)rr * 1024, ws + (which ? WS_V8 : WS_U8) + (size_t)rr * 128, (float*)(ws + WS_UVINV) + 2 * rr + which, lane); }
    GRID_SYNC();

    if constexpr (last < 7) return;
    for (int m = gw; m < T_TOK; m += NGW) rms_rows_to_bf16<1, NOISEQ>(p.out, ((const float*)(ws + WS_CONST)) + C_NFFN, (bf16_t*)(ws + WS_XN), m, NGW, T_TOK, lane);
    GRID_SYNC();

    if constexpr (last < 8) return;
    {
        pg8::Gemm g{(const bf16_t*)(ws + WS_XN), (const bf16_t*)(ws + WS_WQT), T_TOK, 2048, 1024}; pg8::StaticOrder S; S.init(T_TOK, 2048, G, bid);
        EpiRoute E{ws, 1, (bf16_t*)(ws + WS_PQ), 2048, 0};
        pg8::gemm_phase<EpiRoute, pg8::StaticOrder>(lds, g, S, E, wave);
    }
    GRID_SYNC();

    if constexpr (last < 9) return;
    peer_route_phase(p, lds, bid, G, wave, lane);
    GRID_SYNC();

    if constexpr (last < 10) return;
    {
        const int nc = ncls, cw = crank * NWAVES + wave, ncw = csize * NWAVES;
#ifndef ZREP
#define ZREP 1
#endif
#ifdef ZDRY
        for (int x = cls; x < 8; x += nc) peer_zpart_class<ZDRY>(p, lds + wave * PZ_WLDS, x, cw, ncw, lane);
        __syncthreads();
#endif
        for (int x = cls; x < 8; x += nc)
            peer_zpart_class<0xffff>(p, lds + wave * PZ_WLDS, x, cw, ncw, lane);
        GRID_SYNC();
        for (int t = gw; t < T_TOK; t += NGW) peer_act_token(p, t, lane);
        GRID_SYNC();
        for (int x = cls; x < 8; x += nc)
            peer_out_class(p, lds + wave * PO_WLDS, x, cw, ncw, lane);
    }
  }
}

extern "C" void kernel_launch(void* const* d_in, const int* in_sizes, int n_in, void* d_out, int out_size, void* d_ws, size_t ws_size, hipStream_t stream) {
    static int grid_blocks = 0;
    if (grid_blocks == 0) {
        if (n_in != 24 || out_size != T_TOK * DM || ws_size < WS_END) { fprintf(stderr, "kernel_launch: unexpected problem (n_in %d, out %d, ws %zu)\n", n_in, out_size, ws_size); grid_blocks = -1; return; }
        int dev = 0, cus = 0, per_cu = 0;
        hipGetDevice(&dev);
        hipDeviceGetAttribute(&cus, hipDeviceAttributeMultiprocessorCount, dev);
        if (hipFuncSetAttribute((const void*)fwd_megakernel<10>, hipFuncAttributeMaxDynamicSharedMemorySize, LDS_TOTAL) != hipSuccess) { fprintf(stderr, "kernel_launch: hipFuncSetAttribute failed\n"); grid_blocks = -1; return; }
        if (hipOccupancyMaxActiveBlocksPerMultiprocessor(&per_cu, (const void*)fwd_megakernel<10>, NTHREADS, LDS_TOTAL) != hipSuccess || per_cu < 1) { fprintf(stderr, "kernel_launch: occupancy query says %d\n", per_cu); per_cu = 1; }
        (void)hipGetLastError();
        grid_blocks = cus;
    }
    if (grid_blocks < 0) return;
    Params p{};
    const float* const* in = (const float* const*)d_in;
    p.x = in[0]; p.mem = in[1]; p.norm_mix = in[2]; p.w_in = in[3]; p.conv_w = in[4]; p.conv_b = in[5];
    p.lru_wa = in[6]; p.lru_ba = in[7]; p.lru_wi = in[8]; p.lru_bi = in[9]; p.lru_lambda = in[10];
    p.q_norm = in[11]; p.k_norm = in[12]; p.idx_k_norm = in[13]; p.mem_norm = in[14]; p.w_mem_kv = in[15];
    p.mem_q_norm = in[16]; p.mem_k_norm = in[17]; p.w_out = in[18]; p.norm_ffn = in[19]; p.peer_wq = in[20];
    p.peer_subkeys = in[21]; p.peer_u = in[22]; p.peer_v = in[23];
    p.out = (float*)d_out; p.ws = (unsigned char*)d_ws;
    (void)hipMemsetAsync((char*)d_ws + WS_CTL, 0, 32768, stream);
    void* args[] = {&p};
#ifdef PROBE_K
#ifndef PROBE_SUB
#define PROBE_SUB 9
#endif
    { static bool once = false; if (!once) { once = true; (void)hipFuncSetAttribute((const void*)fwd_megakernel<PROBE_K, PROBE_SUB>, hipFuncAttributeMaxDynamicSharedMemorySize, LDS_TOTAL); }
      (void)hipLaunchCooperativeKernel((const void*)fwd_megakernel<PROBE_K, PROBE_SUB>, dim3(grid_blocks), dim3(NTHREADS), args, LDS_TOTAL, stream);
      (void)hipMemsetAsync((char*)d_ws + WS_CTL, 0, 32768, stream); }
#endif
    hipError_t e = hipLaunchCooperativeKernel((const void*)fwd_megakernel<10>, dim3(grid_blocks), dim3(NTHREADS), args, LDS_TOTAL, stream);
    if (e != hipSuccess) fprintf(stderr, "kernel_launch: cooperative launch failed: %s (grid %d)\n", hipGetErrorString(e), grid_blocks);
}
```

```cpp
#include <hip/hip_runtime.h>
#include <hip/hip_cooperative_groups.h>
#include <cstdio>
namespace cg = cooperative_groups;

#define LAS __attribute__((address_space(3)))
#define LDS_WAIT() asm volatile("s_waitcnt lgkmcnt(0)" ::: "memory")
typedef unsigned short bf16_t;
typedef short bf16x8 __attribute__((ext_vector_type(8)));
typedef float f32x4 __attribute__((ext_vector_type(4)));
typedef float f32x2 __attribute__((ext_vector_type(2)));
typedef unsigned u32x4 __attribute__((ext_vector_type(4)));
typedef unsigned u32x2 __attribute__((ext_vector_type(2)));

constexpr int T_TOK = 32768, DM = 1024, SEQ = 4096, NBATCH = 8, MEMT = 256;
constexpr int N1 = 5376;
constexpr int NGATE = 4096;
constexpr int NWAVES = 8, NTHREADS = 512;
constexpr float EPS = 1e-6f;

constexpr size_t MiB = 1ull << 20;
constexpr size_t WS_CTL = 0;
constexpr size_t WS_CONST = 65536;
constexpr int C_CONVW = 0, C_CONVB = 4096, C_LBA = 5120, C_LBI = 6144, C_LAM = 7168, C_QN = 8192, C_KN = 8320, C_IKN = 8448, C_MQN = 8512, C_MKN = 8768, C_NFFN = 9024, C_END = 10048;
constexpr size_t WS_ROPE64 = 1 * MiB;
constexpr size_t WS_ROPE32 = 3 * MiB;
constexpr size_t WS_LRUS = 4 * MiB;
constexpr size_t WS_WAT = 6 * MiB;
constexpr size_t WS_WIT = 6 * MiB + 256 * 1024;
constexpr size_t WS_SUBK = 7 * MiB;
constexpr size_t WS_MN = 8 * MiB;
constexpr size_t WS_MKV = 12 * MiB;
constexpr size_t WS_MKN = 20 * MiB;
constexpr size_t WS_MVT = 24 * MiB;
constexpr size_t WS_W1T = 28 * MiB;
constexpr size_t WS_W1TB = 34 * MiB;
constexpr int N1F = 4608, N1B = 768;
constexpr size_t WS_WGT = 40 * MiB;
constexpr size_t WS_WOT = 48 * MiB;
constexpr size_t WS_WKVT = 50 * MiB;
constexpr size_t WS_WQT = 54 * MiB;
constexpr size_t WS_KN = 60 * MiB;
constexpr size_t WS_KIN = 76 * MiB;
constexpr size_t WS_IDX = 80 * MiB;
constexpr size_t WS_XN = 96 * MiB;
constexpr size_t WS_LX = 160 * MiB;
constexpr size_t WS_GG = 224 * MiB;
constexpr size_t WS_Q = 288 * MiB;
constexpr size_t WS_MQ = 352 * MiB;
constexpr size_t WS_KR = 416 * MiB;
constexpr size_t WS_V = 432 * MiB;
constexpr size_t WS_QI = 448 * MiB;
constexpr size_t WS_KW = 480 * MiB;
constexpr size_t WS_K8 = 496 * MiB;
constexpr size_t WS_SSQ = 504 * MiB;
constexpr size_t WS_RSTD = 506 * MiB;
constexpr size_t WS_END = 508 * MiB;
constexpr float K8_SCALE = 8.0f;
constexpr size_t WS_V8A = 60 * MiB;
constexpr float V8_SCALE = 16.0f, P8_SCALE = 128.0f;
constexpr float X8_SCALE = 8.0f, W8_SCALE = 64.0f;
constexpr int   XW_E8M0 = 127 - 3 - 6;
constexpr size_t WS_MG = WS_LX;
constexpr size_t WS_PQ = WS_LX;
constexpr size_t WS_UB = WS_Q;
constexpr size_t WS_VB = WS_Q + 32 * MiB;
constexpr size_t WS_EIDX = WS_MQ;
constexpr size_t WS_EG = WS_MQ + 16 * MiB;

constexpr int LDS_BYTES = 156672;
constexpr int LDS_XB_OFF = LDS_BYTES, LDS_TOTAL = LDS_BYTES + 16;

struct Params {
    const float* x; const float* mem; const float* norm_mix; const float* w_in; const float* conv_w; const float* conv_b;
    const float* lru_wa; const float* lru_ba; const float* lru_wi; const float* lru_bi; const float* lru_lambda;
    const float* q_norm; const float* k_norm; const float* idx_k_norm; const float* mem_norm; const float* w_mem_kv;
    const float* mem_q_norm; const float* mem_k_norm; const float* w_out; const float* norm_ffn; const float* peer_wq;
    const float* peer_subkeys; const float* peer_u; const float* peer_v;
    float* out; unsigned char* ws;
};

typedef float f32x2_t_ __attribute__((ext_vector_type(2)));
typedef __bf16 bf16x2_t_ __attribute__((ext_vector_type(2)));
__device__ __forceinline__ unsigned pk2(float lo, float hi) { const f32x2_t_ v = {lo, hi}; const bf16x2_t_ b = __builtin_convertvector(v, bf16x2_t_); return __builtin_bit_cast(unsigned, b); }
__device__ __forceinline__ unsigned f2bf(float f) { return (unsigned)__builtin_bit_cast(unsigned short, (__bf16)f); }
__device__ __forceinline__ float bf2f(unsigned short b) { return __uint_as_float(((unsigned)b) << 16); }
__device__ __forceinline__ float bflo(unsigned u) { return __uint_as_float(u << 16); }
__device__ __forceinline__ float bfhi(unsigned u) { return __uint_as_float(u & 0xffff0000u); }
__device__ __forceinline__ float frcp(float x) { return __builtin_amdgcn_rcpf(x); }
__device__ __forceinline__ float sigmoidf_(float x) { return frcp(1.0f + __expf(-x)); }
__device__ __forceinline__ float gelu_tanh(float x) { const float u = 1.5957691216057308f * (x + 0.044715f * x * x * x); return x * frcp(1.0f + __expf(-u)); }
#define DPP_ROR(x, n) __builtin_bit_cast(float, __builtin_amdgcn_update_dpp(0, __builtin_bit_cast(int, (x)), 0x120 + (n), 0xf, 0xf, true))
__device__ __forceinline__ float row_sum(float v) { v += DPP_ROR(v, 8); v += DPP_ROR(v, 4); v += DPP_ROR(v, 2); v += DPP_ROR(v, 1); return v; }
__device__ __forceinline__ float row_max(float v) { v = fmaxf(v, DPP_ROR(v, 8)); v = fmaxf(v, DPP_ROR(v, 4)); v = fmaxf(v, DPP_ROR(v, 2)); v = fmaxf(v, DPP_ROR(v, 1)); return v; }
__device__ __forceinline__ float row_min(float v) { v = fminf(v, DPP_ROR(v, 8)); v = fminf(v, DPP_ROR(v, 4)); v = fminf(v, DPP_ROR(v, 2)); v = fminf(v, DPP_ROR(v, 1)); return v; }
__device__ __forceinline__ float x16_sum(float v) { const auto r = __builtin_amdgcn_permlane16_swap(__float_as_uint(v), __float_as_uint(v), false, false); return __uint_as_float(r[0]) + __uint_as_float(r[1]); }
__device__ __forceinline__ float x32_sum(float v) { const auto r = __builtin_amdgcn_permlane32_swap(__float_as_uint(v), __float_as_uint(v), false, false); return __uint_as_float(r[0]) + __uint_as_float(r[1]); }
__device__ __forceinline__ float x16_max(float v) { const auto r = __builtin_amdgcn_permlane16_swap(__float_as_uint(v), __float_as_uint(v), false, false); return fmaxf(__uint_as_float(r[0]), __uint_as_float(r[1])); }
__device__ __forceinline__ float x32_max(float v) { const auto r = __builtin_amdgcn_permlane32_swap(__float_as_uint(v), __float_as_uint(v), false, false); return fmaxf(__uint_as_float(r[0]), __uint_as_float(r[1])); }
__device__ __forceinline__ float x16_min(float v) { const auto r = __builtin_amdgcn_permlane16_swap(__float_as_uint(v), __float_as_uint(v), false, false); return fminf(__uint_as_float(r[0]), __uint_as_float(r[1])); }
__device__ __forceinline__ float x32_min(float v) { const auto r = __builtin_amdgcn_permlane32_swap(__float_as_uint(v), __float_as_uint(v), false, false); return fminf(__uint_as_float(r[0]), __uint_as_float(r[1])); }
__device__ __forceinline__ float wave_sum(float v) { return x32_sum(x16_sum(row_sum(v))); }
__device__ __forceinline__ float wave_max(float v) { return x32_max(x16_max(row_max(v))); }
__device__ __forceinline__ float wave_min(float v) { return x32_min(x16_min(row_min(v))); }
__device__ __forceinline__ unsigned wave_incl_scan(unsigned v, int lane, unsigned& total) {
    unsigned s = v;
    s += (unsigned)__builtin_amdgcn_update_dpp(0, (int)s, 0x111, 0xf, 0xf, true); s += (unsigned)__builtin_amdgcn_update_dpp(0, (int)s, 0x112, 0xf, 0xf, true);
    s += (unsigned)__builtin_amdgcn_update_dpp(0, (int)s, 0x114, 0xf, 0xf, true); s += (unsigned)__builtin_amdgcn_update_dpp(0, (int)s, 0x118, 0xf, 0xf, true);
    const unsigned t0 = (unsigned)__builtin_amdgcn_readlane((int)s, 15), t1 = (unsigned)__builtin_amdgcn_readlane((int)s, 31), t2 = (unsigned)__builtin_amdgcn_readlane((int)s, 47), t3 = (unsigned)__builtin_amdgcn_readlane((int)s, 63);
    const int g = lane >> 4;
    total = t0 + t1 + t2 + t3;
    return s + (g > 0 ? t0 : 0u) + (g > 1 ? t1 : 0u) + (g > 2 ? t2 : 0u);
}
__device__ __forceinline__ unsigned wave_excl_scan(unsigned v, int lane) { unsigned tot; return wave_incl_scan(v, lane, tot) - v; }
__device__ __forceinline__ bf16x8 pack8(const float* v) {
    u32x4 w; w.x = pk2(v[0], v[1]); w.y = pk2(v[2], v[3]); w.z = pk2(v[4], v[5]); w.w = pk2(v[6], v[7]);
    return __builtin_bit_cast(bf16x8, w);
}
__device__ __forceinline__ void unpack8(u32x4 w, float* v) {
    v[0] = bflo(w.x); v[1] = bfhi(w.x); v[2] = bflo(w.y); v[3] = bfhi(w.y); v[4] = bflo(w.z); v[5] = bfhi(w.z); v[6] = bflo(w.w); v[7] = bfhi(w.w);
}
__device__ __forceinline__ int fresh_lane() { unsigned m = 0xffffffffu; asm volatile("" : "+s"(m)); return (int)__builtin_amdgcn_mbcnt_hi(m, __builtin_amdgcn_mbcnt_lo(m, 0u)); }
#define MFMA16(a, b, c) __builtin_amdgcn_mfma_f32_16x16x32_bf16((a), (b), (c), 0, 0, 0)


#define XB_TMO      128
#define XB_XCNT(j)  (256  + 64 * (j))
#define XB_XSUB(j)  (1280 + 64 * (j))
#define XB_XGEN(j)  (2304 + 64 * (j))
#define XB_TOP      3328
#define XB_TOPGEN   3392
#define XCD_BAR_WORDS 3456
#define XB_SPIN_CAP (1u << 23)
__device__ __forceinline__ unsigned xb_ld(unsigned* p)              { return __hip_atomic_load(p, __ATOMIC_RELAXED, __HIP_MEMORY_SCOPE_AGENT); }
__device__ __forceinline__ unsigned xb_add(unsigned* p, unsigned v) { return __hip_atomic_fetch_add(p, v, __ATOMIC_RELAXED, __HIP_MEMORY_SCOPE_AGENT); }
__device__ __forceinline__ unsigned xb_xcc_id() { return (unsigned)__builtin_amdgcn_s_getreg((3 << 11) | 20) & 0xFu; }
#define XB_SPIN(cond, bar) do { unsigned _sp = 0; while (cond) { __builtin_amdgcn_s_sleep(1); \
    if ((++_sp & 255u) == 0u) { if (xb_ld(&(bar)[XB_TMO])) break; if (_sp > XB_SPIN_CAP) { atomicAdd(&(bar)[XB_TMO], 1u); break; } } } } while (0)
struct XcdBarrier { unsigned* bar; unsigned x; volatile LAS unsigned* st; };
__device__ __forceinline__ XcdBarrier xcd_barrier_post(unsigned* bar, volatile LAS unsigned* st, int wave_id) {
    XcdBarrier b; b.bar = bar; b.x = xb_xcc_id(); b.st = st;
    if (wave_id == 0 && fresh_lane() == 0) (void)xb_add(&bar[XB_XCNT(b.x)], 1u);
    return b;
}
__device__ __forceinline__ void xcd_barrier_complete(unsigned* bar, unsigned x, unsigned& nloc, unsigned& nx) {
    const unsigned G = gridDim.x * gridDim.y * gridDim.z;
    unsigned sum, cnt, mine, sp = 0u;
    for (;;) {
        sum = 0u; cnt = 0u; mine = 0u;
#pragma unroll
        for (unsigned j = 0; j < 16; ++j) { const unsigned c = xb_ld(&bar[XB_XCNT(j)]); sum += c; cnt += (c > 0u) ? 1u : 0u; mine = (j == x) ? c : mine; }
        if (sum == G) break;
        __builtin_amdgcn_s_sleep(1);
        if ((++sp & 255u) == 0u) { if (xb_ld(&bar[XB_TMO])) break; if (sp > XB_SPIN_CAP) { atomicAdd(&bar[XB_TMO], 1u); break; } }
    }
    nloc = mine > 0u ? mine : 1u; nx = cnt > 0u ? cnt : 1u;
}
__device__ __forceinline__ void xcd_barrier(const XcdBarrier& b, int wave_id) {
    asm volatile("s_waitcnt vmcnt(0)" ::: "memory");
    __syncthreads();
    if (wave_id == 0 && fresh_lane() == 0) {
        unsigned* bar = b.bar;
        __builtin_amdgcn_s_waitcnt(0);
        unsigned nloc = b.st[0], nx = b.st[1];
        if (nloc == 0u) { xcd_barrier_complete(bar, b.x, nloc, nx); b.st[0] = nloc; b.st[1] = nx; }
        const unsigned old = xb_add(&bar[XB_XSUB(b.x)], 1u);
        const unsigned gen = old / nloc;
        if (old + 1u == (gen + 1u) * nloc) {
            __builtin_amdgcn_fence(__ATOMIC_RELEASE, "agent");
            asm volatile("s_waitcnt vmcnt(0)" ::: "memory");
            const unsigned og = xb_add(&bar[XB_TOP], 1u);
            const unsigned tg = og / nx;
            if (og + 1u == (tg + 1u) * nx) xb_add(&bar[XB_TOPGEN], 1u);
            else XB_SPIN(xb_ld(&bar[XB_TOPGEN]) == tg, bar);
            __builtin_amdgcn_fence(__ATOMIC_ACQUIRE, "agent");
            xb_add(&bar[XB_XGEN(b.x)], 1u);
            asm volatile("s_waitcnt vmcnt(0)" ::: "memory");
        } else {
            XB_SPIN(xb_ld(&bar[XB_XGEN(b.x)]) == gen, bar);
            __builtin_amdgcn_fence(__ATOMIC_ACQUIRE, "agent");
            asm volatile("s_waitcnt vmcnt(0)" ::: "memory");
        }
    }
    __syncthreads();
}

namespace pg8 {
typedef int i32x4_t __attribute__((ext_vector_type(4)));
typedef int i32x8_t __attribute__((ext_vector_type(8)));
__device__ __forceinline__ i32x8_t cat8(bf16x8 a, bf16x8 b) { return __builtin_shufflevector(__builtin_bit_cast(i32x4_t, a), __builtin_bit_cast(i32x4_t, b), 0, 1, 2, 3, 4, 5, 6, 7); }
constexpr int BM = 256, BK = 64, HALF = 128, HTB = HALF * BK * 2, STAGE_BYTES = 8 * HTB, NXCD = 8, WGM = 8;
__host__ __device__ __forceinline__ int lds_byte(int r, int c) { const int st = (r >> 4) * 2 + (c >> 5), rr = r & 15, cc = c & 31, ob = rr * 64 + cc * 2; return st * 1024 + (ob ^ (((ob >> 9) & 1) << 5)); }
__host__ __device__ __forceinline__ void stage_rc(int b, int& R, int& C) { const int st = b / 1024, sb = b % 1024, swz = sb ^ (((sb >> 9) & 1) << 5); R = (st >> 1) * 16 + swz / 64; C = (st & 1) * 32 + (swz % 64) / 2; }
__host__ __device__ __forceinline__ int perm32(int rho) { const int n = rho >> 4, i = rho & 15; return 8 * (i >> 2) + 4 * n + (i & 3); }
struct Unit { int pm, pn; };
struct Gemm { const bf16_t* A; const bf16_t* Bt; int M, N, K; };
struct StaticOrder {
    int nM, nN, nwg, G, c;
    __host__ __device__ void init(int M, int N, int G_, int c_) { nM = M / BM; nN = N / BM; nwg = nM * nN; G = G_; c = c_; }
    __host__ __device__ bool next(int i, Unit& u) const {
        const long L = (long)i * G + c; if (L >= nwg) return false;
        int wgid = (int)L; { const int q = nwg / NXCD, r = nwg % NXCD, xcd = wgid % NXCD, off = wgid / NXCD; wgid = (xcd < r ? xcd * (q + 1) : r * (q + 1) + (xcd - r) * q) + off; }
        const int nig = WGM * nN, gid = wgid / nig, fm = gid * WGM, gsz = (nM - fm) < WGM ? (nM - fm) : WGM;
        u.pm = fm + ((wgid % nig) % gsz); u.pn = (wgid % nig) / gsz; return true;
    }
    __device__ __forceinline__ void a_ready(const Unit&) const {}
    __device__ __forceinline__ void done(const Unit&) const {}
};

template <class Epi, class Sched, bool SKIPQ = false, int F8SC = 0>
__device__ __forceinline__ void gemm_phase(LAS unsigned char* lds, const Gemm g, const Sched& S, const Epi& E, int wave_id) {
    const int tid = (wave_id << 6) | fresh_lane(), wid = wave_id, lane = tid & 63, wr = wid >> 2, wc = wid & 3, fr = lane & 15, fq = lane >> 4;
    const int K = g.K, nt = K / BK;
    unsigned voffA[2], voffB[2];
#pragma unroll
    for (int i = 0; i < 2; ++i) { int R, C; stage_rc(tid * 16 + i * 8192, R, C); const int Rb = Epi::PERM ? ((R & ~31) + perm32(R & 31)) : R;
        voffA[i] = (unsigned)(R * K + C) * 2u; voffB[i] = (unsigned)(Rb * K + C) * 2u; }
    const size_t kstep = (size_t)(BK * 2);
    const size_t hstep = (size_t)HALF * K * 2;
    const size_t tstep = 2 * hstep;
    const unsigned ldsw = (unsigned)wid * 1024u;
    const int aoff = lds_byte(wr * 64 + fr, fq * 8), boff = lds_byte(wc * 32 + fr, fq * 8);
#define PG8_SA(b, h) (((b) * 2 + (h)) * HTB)
#define PG8_SB(b, h) ((4 + (b) * 2 + (h)) * HTB)
#define PG8_STAGE(bufoff, gbase, voff) do { _Pragma("unroll") for (int _i = 0; _i < 2; ++_i) \
        __builtin_amdgcn_global_load_lds((const unsigned*)((const char*)(gbase) + (voff)[_i]), (LAS unsigned*)(lds + (bufoff) + ldsw + _i * 8192), 16, 0, 0); } while (0)
#define PG8_LDA(dst, b, h) do { _Pragma("unroll") for (int m = 0; m < 4; ++m) dst[m] = __builtin_shufflevector(*(const LAS i32x4_t*)(lds + PG8_SA(b, h) + aoff + m * 2048), *(const LAS i32x4_t*)(lds + PG8_SA(b, h) + aoff + m * 2048 + 1024), 0, 1, 2, 3, 4, 5, 6, 7); } while (0)
#define PG8_LDB(dst, b, h) do { _Pragma("unroll") for (int n = 0; n < 2; ++n) dst[n] = __builtin_shufflevector(*(const LAS i32x4_t*)(lds + PG8_SB(b, h) + boff + n * 2048), *(const LAS i32x4_t*)(lds + PG8_SB(b, h) + boff + n * 2048 + 1024), 0, 1, 2, 3, 4, 5, 6, 7); } while (0)
#define PG8_HALF(v, k) __builtin_bit_cast(bf16x8, __builtin_shufflevector((v), (v), 4 * (k), 4 * (k) + 1, 4 * (k) + 2, 4 * (k) + 3))
#define PG8_MMA(ai, bj, At, Bt) do { __builtin_amdgcn_s_setprio(1); _Pragma("unroll") for (int m = 0; m < 4; ++m) _Pragma("unroll") for (int n = 0; n < ((SKIPQ && (bj) == 1) ? 1 : 2); ++n) { \
        if constexpr (F8SC != 0) asm volatile("v_mfma_scale_f32_16x16x128_f8f6f4 %0, %1, %2, %0, %3, %4 op_sel_hi:[0,0,0]" : "+v"(acc[ai][bj][m][n]) : "v"(Bt[n]), "v"(At[m]), "v"(sclA), "v"(sclB)); \
        else { acc[ai][bj][m][n] = __builtin_amdgcn_mfma_f32_16x16x32_bf16(PG8_HALF(Bt[n], 0), PG8_HALF(At[m], 0), acc[ai][bj][m][n], 0, 0, 0); \
               acc[ai][bj][m][n] = __builtin_amdgcn_mfma_f32_16x16x32_bf16(PG8_HALF(Bt[n], 1), PG8_HALF(At[m], 1), acc[ai][bj][m][n], 0, 0, 0); } } __builtin_amdgcn_s_setprio(0); } while (0)
#define PG8_WAIT_V(n) asm volatile("s_waitcnt vmcnt(" #n ")" ::: "memory")
#define PG8_WAIT_L(n) asm volatile("s_waitcnt lgkmcnt(" #n ")" ::: "memory")
#define PG8_BAR __builtin_amdgcn_s_barrier()
#define PG8_SCHED __builtin_amdgcn_sched_barrier(0)
    Unit cur, nxt; int ui = 0;
    if (!S.next(0, cur)) return;
    int sclA = F8SC * 0x01010101, sclB = 0x7f7f7f7f;
    if constexpr (F8SC != 0) asm volatile("" : "+v"(sclA), "+v"(sclB));
    f32x4 acc[2][2][4][2];
#pragma unroll
    for (int a = 0; a < 2; ++a)
#pragma unroll
        for (int b = 0; b < 2; ++b)
#pragma unroll
            for (int m = 0; m < 4; ++m)
#pragma unroll
                for (int n = 0; n < 2; ++n) acc[a][b][m][n] = (f32x4){0.f, 0.f, 0.f, 0.f};
    i32x8_t At[4], B0[2], B1[2];
    const char* cA = (const char*)g.A + (size_t)cur.pm * tstep; const char* cB = (const char*)g.Bt + (size_t)cur.pn * tstep;
    S.a_ready(cur);
    PG8_STAGE(PG8_SB(0, 0), cB, voffB); PG8_STAGE(PG8_SA(0, 0), cA, voffA); PG8_STAGE(PG8_SB(0, 1), cB + hstep, voffB); PG8_STAGE(PG8_SA(0, 1), cA + hstep, voffA);
    if (wr == 1) PG8_BAR;
    PG8_WAIT_V(4); PG8_BAR;
    PG8_STAGE(PG8_SB(1, 0), cB + kstep, voffB); PG8_STAGE(PG8_SA(1, 0), cA + kstep, voffA); PG8_STAGE(PG8_SB(1, 1), cB + hstep + kstep, voffB);
    PG8_WAIT_V(6); PG8_BAR;
    for (;;) {
        const bool has_next = S.next(ui + 1, nxt);
        const char* nA = has_next ? (const char*)g.A + (size_t)nxt.pm * tstep : cA; const char* nB = has_next ? (const char*)g.Bt + (size_t)nxt.pn * tstep : cB;
#pragma unroll 1
        for (int t = 0; t < nt; t += 2) {
            const bool last = (t == nt - 2);
            const char* a1 = cA + (size_t)(t + 1) * kstep;
            const char* a2 = last ? nA : cA + (size_t)(t + 2) * kstep; const char* b2 = last ? nB : cB + (size_t)(t + 2) * kstep;
            const char* a3 = a2 + kstep; const char* b3 = b2 + kstep;
            if (last && has_next) S.a_ready(nxt);
            PG8_LDB(B0, 0, 0); PG8_SCHED; PG8_LDA(At, 0, 0); PG8_STAGE(PG8_SA(1, 1), a1 + hstep, voffA);
            PG8_WAIT_L(8); PG8_BAR; PG8_WAIT_L(0); PG8_MMA(0, 0, At, B0); PG8_BAR; PG8_SCHED;
            PG8_LDB(B1, 0, 1); PG8_STAGE(PG8_SB(0, 0), b2, voffB);
            PG8_BAR; PG8_WAIT_L(0); PG8_MMA(0, 1, At, B1); PG8_BAR;
            PG8_LDA(At, 0, 1); PG8_STAGE(PG8_SA(0, 0), a2, voffA);
            PG8_BAR; PG8_WAIT_L(0); PG8_MMA(1, 0, At, B0); PG8_BAR; PG8_SCHED;
            PG8_STAGE(PG8_SB(0, 1), b2 + hstep, voffB);
            PG8_WAIT_V(6); PG8_BAR; PG8_MMA(1, 1, At, B1); PG8_BAR;
            PG8_LDB(B0, 1, 0); PG8_SCHED; PG8_LDA(At, 1, 0); PG8_STAGE(PG8_SA(0, 1), a2 + hstep, voffA);
            PG8_WAIT_L(8); PG8_BAR; PG8_WAIT_L(0); PG8_MMA(0, 0, At, B0); PG8_BAR; PG8_SCHED;
            PG8_LDB(B1, 1, 1); PG8_STAGE(PG8_SB(1, 0), b3, voffB);
            PG8_BAR; PG8_WAIT_L(0); PG8_MMA(0, 1, At, B1); PG8_BAR;
            PG8_LDA(At, 1, 1); PG8_STAGE(PG8_SA(1, 0), a3, voffA);
            PG8_BAR; PG8_WAIT_L(0); PG8_MMA(1, 0, At, B0); PG8_BAR; PG8_SCHED;
            PG8_STAGE(PG8_SB(1, 1), b3 + hstep, voffB);
            PG8_WAIT_V(6); PG8_BAR; PG8_MMA(1, 1, At, B1); PG8_BAR;
        }
        if constexpr (F8SC != 0) asm volatile("s_nop 15\n\ts_nop 7" ::: "memory");
        E(acc, cur, wr, wc, fr, fq); S.done(cur);
        if (!has_next) break;
#pragma unroll
        for (int a = 0; a < 2; ++a)
#pragma unroll
            for (int b = 0; b < 2; ++b)
#pragma unroll
                for (int m = 0; m < 4; ++m)
#pragma unroll
                    for (int n = 0; n < 2; ++n) acc[a][b][m][n] = (f32x4){0.f, 0.f, 0.f, 0.f};
        cur = nxt; cA = nA; cB = nB; ++ui;
    }
    PG8_WAIT_V(0);
    if (wr == 0) PG8_BAR;
    PG8_BAR;
#undef PG8_SA
#undef PG8_SB
#undef PG8_STAGE
#undef PG8_LDA
#undef PG8_LDB
#undef PG8_HALF
#undef PG8_MMA
#undef PG8_WAIT_V
#undef PG8_WAIT_L
#undef PG8_BAR
#undef PG8_SCHED
}
}

__device__ __forceinline__ unsigned cvt_pk_bf16(float lo, float hi) { unsigned r; asm volatile("v_cvt_pk_bf16_f32 %0, %1, %2" : "=v"(r) : "v"(lo), "v"(hi)); return r; }

struct EpiRoute {
    static constexpr bool PERM = true;
    unsigned char* ws; int mode; bf16_t* O; int ldc; int pn0 = 0;
    __device__ __forceinline__ void operator()(const f32x4 (&acc)[2][2][4][2], const pg8::Unit& u, int wr, int wc, int fr, int fq) const {
        const int row0 = u.pm * 256 + wr * 64 + fr;
        bf16_t* base; int ld, colt; bool gelu = false;
        if (mode == 0) {
            const int pn = u.pn + pn0;
            if (pn < 4) { base = (bf16_t*)(ws + WS_LX); ld = 1024; colt = pn * 256; }
            else if (pn < 8) { base = (bf16_t*)(ws + WS_GG); ld = 1024; colt = (pn - 4) * 256; gelu = true; }
            else if (pn < 12) { base = (bf16_t*)(ws + WS_Q); ld = 1024; colt = (pn - 8) * 256; }
            else if (pn < 16) { base = (bf16_t*)(ws + WS_MQ); ld = 1024; colt = (pn - 12) * 256; }
            else if (pn == 16) { base = (bf16_t*)(ws + WS_KR); ld = 256; colt = 0; }
            else if (pn == 17) { base = (bf16_t*)(ws + WS_V); ld = 256; colt = 0; }
            else if (pn < 20) { base = (bf16_t*)(ws + WS_QI); ld = 512; colt = (pn - 18) * 256; }
            else { base = (bf16_t*)(ws + WS_KW); ld = 256; colt = 0; }
        } else { base = O; ld = ldc; colt = u.pn * 256; }
        const int col0 = colt + wc * 32 + 8 * fq;
#pragma unroll
        for (int ai = 0; ai < 2; ++ai)
#pragma unroll
            for (int m = 0; m < 4; ++m) { bf16_t* rowp = base + (size_t)(row0 + ai * 128 + m * 16) * ld + col0;
#pragma unroll
                for (int bj = 0; bj < 2; ++bj) { f32x4 v0 = acc[ai][bj][m][0], v1 = acc[ai][bj][m][1];
                    if (gelu) {
#pragma unroll
                        for (int j = 0; j < 4; ++j) { v0[j] = gelu_tanh(v0[j]); v1[j] = gelu_tanh(v1[j]); } }
                    u32x4 w; w.x = cvt_pk_bf16(v0[0], v0[1]); w.y = cvt_pk_bf16(v0[2], v0[3]); w.z = cvt_pk_bf16(v1[0], v1[1]); w.w = cvt_pk_bf16(v1[2], v1[3]);
                    *(u32x4*)(rowp + bj * 128) = w; } }
    }
};

struct EpiMerge {
    static constexpr bool PERM = false;
    const bf16_t* Y0; const bf16_t* Y1; const bf16_t* Y2; bf16_t* MG;
    static __device__ __forceinline__ void swap16v(u32x4& v) {
        unsigned x = v.x, y = v.y, z = v.z, w = v.w;
        const auto r0 = __builtin_amdgcn_permlane16_swap(x, z, false, false); const auto r1 = __builtin_amdgcn_permlane16_swap(y, w, false, false);
        v.x = r0[0]; v.z = r0[1]; v.y = r1[0]; v.w = r1[1]; }
    __device__ __forceinline__ void operator()(const f32x4 (&acc)[2][2][4][2], const pg8::Unit& u, int wr, int wc, int fr, int fq) const {
        const unsigned ch = (unsigned)(u.pn * 64 + wc * 16 + (fq & ~1) * 4);
        const unsigned off0 = (unsigned)(u.pm * 256 + wr * 64 + fr + (fq & 1) * 16) * 1024u + ch;
        u32x4 y0[2][2], y1[2][2], y2[2][2];
#pragma unroll
        for (int ai = 0; ai < 2; ++ai)
#pragma unroll
            for (int mp = 0; mp < 2; ++mp) { const unsigned off = off0 + (unsigned)(ai * 128 + mp * 32) * 1024u;
                y0[ai][mp] = *(const u32x4*)(Y0 + off); y1[ai][mp] = *(const u32x4*)(Y1 + off); y2[ai][mp] = *(const u32x4*)(Y2 + off); }
        __builtin_amdgcn_sched_barrier(0);
        f32x4 sg[2][3][4];
#pragma unroll
        for (int ai = 0; ai < 2; ++ai)
#pragma unroll
            for (int m = 0; m < 4; ++m)
#pragma unroll
                for (int e = 0; e < 4; ++e) { sg[ai][0][m][e] = sigmoidf_(acc[ai][0][m][0][e]); sg[ai][1][m][e] = sigmoidf_(acc[ai][0][m][1][e]); sg[ai][2][m][e] = sigmoidf_(acc[ai][1][m][0][e]); }
        __builtin_amdgcn_sched_barrier(0);
#pragma unroll
        for (int ai = 0; ai < 2; ++ai)
#pragma unroll
            for (int mp = 0; mp < 2; ++mp) {
                u32x4 a = y0[ai][mp], b = y1[ai][mp], c = y2[ai][mp];
                swap16v(a); swap16v(b); swap16v(c);
                u32x4 w;
#pragma unroll
                for (int h = 0; h < 2; ++h) { const int m = 2 * mp + h;
                    const unsigned ax = h ? a.z : a.x, ay = h ? a.w : a.y, bx = h ? b.z : b.x, by = h ? b.w : b.y, cx = h ? c.z : c.x, cy = h ? c.w : c.y;
                    const f32x4 g0 = sg[ai][0][m], g1 = sg[ai][1][m], g2 = sg[ai][2][m];
                    float o[4];
                    o[0] = g0[0] * bflo(ax) + g1[0] * bflo(bx) + g2[0] * bflo(cx);
                    o[1] = g0[1] * bfhi(ax) + g1[1] * bfhi(bx) + g2[1] * bfhi(cx);
                    o[2] = g0[2] * bflo(ay) + g1[2] * bflo(by) + g2[2] * bflo(cy);
                    o[3] = g0[3] * bfhi(ay) + g1[3] * bfhi(by) + g2[3] * bfhi(cy);
                    if (h == 0) { w.x = pk2(o[0], o[1]); w.y = pk2(o[2], o[3]); } else { w.z = pk2(o[0], o[1]); w.w = pk2(o[2], o[3]); } }
                swap16v(w);
                *(u32x4*)(MG + off0 + (unsigned)(ai * 128 + mp * 32) * 1024u) = w;
            }
    }
};

struct EpiOut {
    static constexpr bool PERM = false;
    const float* X; float* OUT; bf16_t* XB; float* SSQ;
    __device__ __forceinline__ void operator()(const f32x4 (&acc)[2][2][4][2], const pg8::Unit& u, int wr, int wc, int fr, int fq) const {
        const unsigned row0 = (unsigned)(u.pm * 256 + wr * 64 + fr);
        const unsigned off0 = row0 * 1024u + (unsigned)(u.pn * 256 + wc * 32 + 4 * fq);
        const unsigned offb = (row0 + (unsigned)(fq & 1) * 16u) * 1024u + (unsigned)(u.pn * 256 + wc * 32 + 4 * (fq & ~1));
        auto loadb = [&](f32x4 (&xv)[2][2][2], int ai, int mp) {
#pragma unroll
            for (int h = 0; h < 2; ++h)
#pragma unroll
                for (int bj = 0; bj < 2; ++bj)
#pragma unroll
                    for (int n = 0; n < 2; ++n) xv[h][bj][n] = *(const f32x4*)(X + (off0 + (unsigned)(ai * 128 + (2 * mp + h) * 16) * 1024u + (unsigned)(bj * 128 + n * 16))); };
        auto procb = [&](const f32x4 (&xv)[2][2][2], int ai, int mp) {
            float ss0 = 0.f, ss1 = 0.f;
#pragma unroll
            for (int bj = 0; bj < 2; ++bj)
#pragma unroll
                for (int n = 0; n < 2; ++n) {
                    const f32x4 v0 = xv[0][bj][n] + acc[ai][bj][2 * mp][n], v1 = xv[1][bj][n] + acc[ai][bj][2 * mp + 1][n];
                    ss0 += (v0[0] * v0[0] + v0[1] * v0[1]) + (v0[2] * v0[2] + v0[3] * v0[3]); ss1 += (v1[0] * v1[0] + v1[1] * v1[1]) + (v1[2] * v1[2] + v1[3] * v1[3]);
                    u32x4 w; w.x = cvt_pk_bf16(v0[0], v0[1]); w.y = cvt_pk_bf16(v0[2], v0[3]); w.z = cvt_pk_bf16(v1[0], v1[1]); w.w = cvt_pk_bf16(v1[2], v1[3]);
                    EpiMerge::swap16v(w);
                    *(u32x4*)(XB + (offb + (unsigned)(ai * 128 + mp * 32) * 1024u + (unsigned)(bj * 128 + n * 16))) = w; }
            ss0 = x32_sum(x16_sum(ss0)); ss1 = x32_sum(x16_sum(ss1));
            if (fq == 0) { float* sq = SSQ + (row0 + (unsigned)(ai * 128 + mp * 32)) * 16u + (unsigned)(u.pn * 4 + wc); sq[0] = ss0; sq[16 * 16] = ss1; } };
        f32x4 xa[2][2][2], xb[2][2][2];
        loadb(xa, 0, 0);
        loadb(xb, 0, 1); procb(xa, 0, 0);
        loadb(xa, 1, 0); procb(xb, 0, 1);
        loadb(xb, 1, 1); procb(xa, 1, 0);
        procb(xb, 1, 1);
    }
};

template <class Ld>
__device__ __forceinline__ void transpose_item(const Ld& ld, bf16_t* WT, int Kd, int k0, int n0, LAS float* scr, int lane) {
    float tv[32];
#pragma unroll
    for (int i = 0; i < 32; ++i) tv[i] = ld(k0 + 2 * i + (lane >> 5), n0 + (lane & 31));
#pragma unroll
    for (int i = 0; i < 32; ++i) scr[(2 * i + (lane >> 5)) * 33 + (lane & 31)] = tv[i];
    LDS_WAIT();
    const int c = lane & 7;
#pragma unroll
    for (int j = 0; j < 4; ++j) { const int n = (lane >> 3) + 8 * j; const LAS float* s = scr + (8 * c) * 33 + n;
        u32x4 o; o.x = pk2(s[0 * 33], s[1 * 33]); o.y = pk2(s[2 * 33], s[3 * 33]); o.z = pk2(s[4 * 33], s[5 * 33]); o.w = pk2(s[6 * 33], s[7 * 33]);
        *(u32x4*)(WT + (size_t)(n0 + n) * Kd + k0 + 8 * c) = o; }
    LDS_WAIT();
}
__device__ __forceinline__ unsigned pk4_fp8(float a, float b, float c, float d, float sc) {
    int w = 0; w = __builtin_amdgcn_cvt_pk_fp8_f32(__builtin_amdgcn_fmed3f(a * sc, -448.f, 448.f), __builtin_amdgcn_fmed3f(b * sc, -448.f, 448.f), w, false);
    w = __builtin_amdgcn_cvt_pk_fp8_f32(__builtin_amdgcn_fmed3f(c * sc, -448.f, 448.f), __builtin_amdgcn_fmed3f(d * sc, -448.f, 448.f), w, true); return (unsigned)w; }
template <class Ld>
__device__ __forceinline__ void transpose_item_f8(const Ld& ld, unsigned char* WT, int Kd, int k0, int n0, LAS float* scr, int lane, float sc) {
    float tv[32];
#pragma unroll
    for (int i = 0; i < 32; ++i) tv[i] = ld(k0 + 2 * i + (lane >> 5), n0 + (lane & 31));
#pragma unroll
    for (int i = 0; i < 32; ++i) scr[(2 * i + (lane >> 5)) * 33 + (lane & 31)] = tv[i];
    LDS_WAIT();
    const int c = lane & 7;
#pragma unroll
    for (int j = 0; j < 4; ++j) { const int n = (lane >> 3) + 8 * j; const LAS float* s = scr + (8 * c) * 33 + n;
        u32x2 o; o.x = pk4_fp8(s[0 * 33], s[1 * 33], s[2 * 33], s[3 * 33], sc); o.y = pk4_fp8(s[4 * 33], s[5 * 33], s[6 * 33], s[7 * 33], sc);
        *(u32x2*)(WT + (size_t)(n0 + n) * Kd + k0 + 8 * c) = o; }
    LDS_WAIT();
}
__device__ __forceinline__ void rms_row_to_fp8(const float* xbase, const float* gain, unsigned char* obase, bf16_t* bbase, int m, int lane, float sc) {
    const f32x4* gr = (const f32x4*)gain + lane; const f32x4* xr = (const f32x4*)(xbase + (size_t)m * 1024) + lane;
    f32x4 v[4], g[4];
#pragma unroll
    for (int j = 0; j < 4; ++j) v[j] = xr[64 * j];
#pragma unroll
    for (int j = 0; j < 4; ++j) g[j] = gr[64 * j];
    float s = 0.f;
#pragma unroll
    for (int j = 0; j < 4; ++j) s += (v[j].x * v[j].x + v[j].y * v[j].y) + (v[j].z * v[j].z + v[j].w * v[j].w);
    const float rstd = rsqrtf(wave_sum(s) * (1.f / 1024.f) + EPS) * sc;
    unsigned* o4 = (unsigned*)(obase + (size_t)m * 1024) + lane;
#pragma unroll
    for (int j = 0; j < 4; ++j) o4[64 * j] = pk4_fp8(v[j].x * g[j].x, v[j].y * g[j].y, v[j].z * g[j].z, v[j].w * g[j].w, rstd);
    if (bbase) { const float rs = rstd * (1.0f / sc); u32x2* o8 = (u32x2*)(bbase + (size_t)m * 1024) + lane;
#pragma unroll
        for (int j = 0; j < 4; ++j) { u32x2 w; w.x = pk2(v[j].x * rs * g[j].x, v[j].y * rs * g[j].y); w.y = pk2(v[j].z * rs * g[j].z, v[j].w * rs * g[j].w); o8[64 * j] = w; } }
}
template <int NB, int NQ = 0> __device__ __forceinline__ void rms_rows_to_bf16(const float* xbase, const float* gain, bf16_t* obase, int m0, int mstride, int mlimit, int lane) {
    const f32x4* gr = (const f32x4*)gain + lane;
    f32x4 v[NB][4]; int mk[NB];
#pragma unroll
    for (int k = 0; k < NB; ++k) { const int m = m0 + k * mstride < mlimit ? m0 + k * mstride : m0; mk[k] = m; const f32x4* xr = (const f32x4*)(xbase + (size_t)m * 1024) + lane;
#pragma unroll
        for (int j = 0; j < 4; ++j) v[k][j] = xr[64 * j]; }
    f32x4 g[4];
#pragma unroll
    for (int j = 0; j < 4; ++j) g[j] = gr[64 * j];
#pragma unroll
    for (int k = 0; k < NB; ++k) { float s = 0.f;
#pragma unroll
        for (int j = 0; j < 4; ++j) s += (v[k][j].x * v[k][j].x + v[k][j].y * v[k][j].y) + (v[k][j].z * v[k][j].z + v[k][j].w * v[k][j].w);
        const float rstd = rsqrtf(wave_sum(s) * (1.f / 1024.f) + EPS);
        u32x2* o8 = (u32x2*)(obase + (size_t)mk[k] * 1024) + lane;
#pragma unroll
        for (int j = 0; j < 4; ++j) { float a0 = v[k][j].x * rstd * g[j].x, a1 = v[k][j].y * rstd * g[j].y, a2 = v[k][j].z * rstd * g[j].z, a3 = v[k][j].w * rstd * g[j].w;
            if (NQ) { a0 = __uint_as_float((__float_as_uint(a0) + 0x00020000u) & 0xFFFC0000u); a1 = __uint_as_float((__float_as_uint(a1) + 0x00020000u) & 0xFFFC0000u); a2 = __uint_as_float((__float_as_uint(a2) + 0x00020000u) & 0xFFFC0000u); a3 = __uint_as_float((__float_as_uint(a3) + 0x00020000u) & 0xFFFC0000u); }
            u32x2 w; w.x = pk2(a0, a1); w.y = pk2(a2, a3); o8[64 * j] = w; } }
}

__device__ __forceinline__ void phase_prologue(const Params& p, LAS unsigned char* lds, int lane, int wave, int gw, int NGW) {
    LAS float* scr = (LAS float*)(lds + wave * 16384);
    unsigned char* ws = p.ws;
    constexpr int I_W1 = 16 * (N1 / 32), I_WG = 16 * (NGATE / 32), I_WO = 16 * 32, I_WKV = 16 * 64, I_WQ = 16 * 64, I_LRU = 16 * 2 * 2;
    constexpr int NITEMS = I_W1 + I_WG + I_WO + I_WKV + I_WQ + I_LRU;
#ifndef PDUP
#define PDUP 0
#endif
#pragma unroll 1
    for (int rep_ = 0; rep_ < (PDUP == 1 ? 2 : 1); ++rep_)
    for (int it = gw; it < NITEMS; it += NGW) {
        int r = it;
        if (r < I_W1) { const int kb = r / (N1 / 32), nb = r % (N1 / 32); const float* W = p.w_in;
            auto ld = [W](int k, int n) -> float { int sc; if (n < 3072) sc = n; else if (n < 4096) sc = n + 1096; else if (n < 5192) sc = n - 1024; else sc = -1; return sc >= 0 ? W[(size_t)k * 8264 + sc] : 0.f; };
            if (nb < N1F / 32) transpose_item_f8(ld, ws + WS_W1T, 1024, kb * 64, nb * 32, scr, lane, W8_SCALE);
            else { auto ld2 = [&ld](int k, int n) -> float { return ld(k, n + N1F); }; transpose_item(ld2, (bf16_t*)(ws + WS_W1TB), 1024, kb * 64, nb * 32 - N1F, scr, lane); }
            continue; } r -= I_W1;
        if (r < I_WG) { const int kb = r / (NGATE / 32), nb = r % (NGATE / 32); const float* W = p.w_in;
            auto ld = [W](int k, int R) -> float { const int pn = R >> 8, bj = (R >> 7) & 1, wc = (R >> 5) & 3, n = (R >> 4) & 1, lo = R & 15; const int br = 2 * bj + n, ch = 64 * pn + 16 * wc + lo;
                return br < 3 ? W[(size_t)k * 8264 + 5192 + 1024 * br + ch] : 0.f; };
            transpose_item_f8(ld, ws + WS_WGT, 1024, kb * 64, nb * 32, scr, lane, W8_SCALE); continue; } r -= I_WG;
        if (r < I_WO) { const int kb = r / 32, nb = r % 32; const float* W = p.w_out;
            auto ld = [W](int k, int n) -> float { return W[(size_t)k * 1024 + n]; };
            transpose_item(ld, (bf16_t*)(ws + WS_WOT), 1024, kb * 64, nb * 32, scr, lane); continue; } r -= I_WO;
        if (r < I_WKV) { const int kb = r / 64, nb = r % 64; const float* W = p.w_mem_kv;
            auto ld = [W](int k, int n) -> float { return W[(size_t)k * 2048 + n]; };
            transpose_item(ld, (bf16_t*)(ws + WS_WKVT), 1024, kb * 64, nb * 32, scr, lane); continue; } r -= I_WKV;
        if (r < I_WQ) { const int kb = r / 64, nb = r % 64; const float* W = p.peer_wq;
            const float* gn = p.norm_ffn;
            auto ld = [W, gn](int k, int n) -> float { return W[(size_t)k * 2048 + n] * gn[k]; };
            transpose_item(ld, (bf16_t*)(ws + WS_WQT), 1024, kb * 64, nb * 32, scr, lane); continue; } r -= I_WQ;
        { const int which = r >> 5, blk = (r >> 1) & 15, nb = r & 1; const float* W = (which ? p.lru_wi : p.lru_wa) + blk * 4096;
            auto ld = [W](int k, int n) -> float { return W[k * 64 + n]; };
            transpose_item(ld, (bf16_t*)(ws + (which ? WS_WIT : WS_WAT)) + blk * 4096, 64, 0, nb * 32, scr, lane); }
    }
    { float* C = (float*)(ws + WS_CONST);
      for (int i = gw * 64 + lane; i < C_END; i += NGW * 64) { float v;
          if (i < C_CONVB) v = p.conv_w[i]; else if (i < C_LBA) v = p.conv_b[i - C_CONVB]; else if (i < C_LBI) v = p.lru_ba[i - C_LBA]; else if (i < C_LAM) v = p.lru_bi[i - C_LBI];
          else if (i < C_QN) v = p.lru_lambda[i - C_LAM]; else if (i < C_KN) v = p.q_norm[i - C_QN]; else if (i < C_IKN) v = p.k_norm[i - C_KN]; else if (i < C_MQN) v = p.idx_k_norm[i - C_IKN];
          else if (i < C_MKN) v = p.mem_q_norm[i - C_MQN]; else if (i < C_NFFN) v = p.mem_k_norm[i - C_MKN]; else v = p.norm_ffn[i - C_NFFN];
          C[i] = v; } }
    { const float* S = p.peer_subkeys; bf16_t* D = (bf16_t*)(ws + WS_SUBK);
      for (int i = gw * 64 + lane; i < 262144 / 4; i += NGW * 64) { const f32x4 v = ((const f32x4*)S)[i]; u32x2 w; w.x = pk2(v.x, v.y); w.y = pk2(v.z, v.w); ((u32x2*)D)[i] = w; } }
    { f32x2* R64 = (f32x2*)(ws + WS_ROPE64); f32x2* R32 = (f32x2*)(ws + WS_ROPE32);
#pragma unroll 1
      for (int rep_ = 0; rep_ < (PDUP == 3 ? 2 : 1); ++rep_)
      for (int e = gw * 64 + lane; e < 4096 * 96; e += NGW * 64) {
          const int pos = e / 96, i = e % 96; const bool is64 = i < 64; const int ii = is64 ? i : i - 64; const float half = is64 ? 64.f : 32.f;
          const float freq = exp2f(-(float)ii / half * 13.287712379549449f);
          const float angf = (float)pos * freq;
          const double a = (double)angf; const double kq = rint(a * 0.15915494309189535); const float rr = (float)(a - kq * 6.283185307179586);
          f32x2 cs; cs.x = __cosf(rr); cs.y = __sinf(rr);
          if (is64) R64[pos * 64 + ii] = cs; else R32[pos * 32 + ii] = cs; } }
#pragma unroll 1
    for (int rep_ = 0; rep_ < (PDUP == 2 ? 2 : 1); ++rep_)
    for (int m = gw; m < T_TOK; m += NGW) rms_row_to_fp8(p.x, p.norm_mix, ws + WS_XN, (bf16_t*)p.out, m, lane, X8_SCALE);
    for (int m = gw; m < NBATCH * MEMT; m += NGW) rms_rows_to_bf16<1>(p.mem, p.mem_norm, (bf16_t*)(ws + WS_MN), m, NGW, NBATCH * MEMT, lane);
}

template <int NB> __device__ __forceinline__ void kprep_tokens(const Params& p, int t0, int tstride, int lane) {
    unsigned char* ws = p.ws;
    const int g = lane >> 5, i = lane & 31, d = lane & 31;
    int tk[NB]; unsigned u0[NB], u1[NB]; float kx[NB], ky[NB]; f32x4 cs64[NB]; f32x2 cs32[NB]; u32x2 vv[NB];
    const float* C = (const float*)(ws + WS_CONST);
    const f32x2 ga = *(const f32x2*)(C + C_KN + 2 * i), gb = *(const f32x2*)(C + C_KN + 64 + 2 * i);
    const float gi0 = C[C_IKN + d], gi1 = C[C_IKN + d + 32];
#pragma unroll
    for (int k = 0; k < NB; ++k) { const int t = t0 + k * tstride < T_TOK ? t0 + k * tstride : t0; tk[k] = t; const int pos = t & (SEQ - 1);
        const bf16_t* src = (const bf16_t*)(ws + WS_KR) + (size_t)t * 256 + g * 128 + 2 * i; u0[k] = *(const unsigned*)src; u1[k] = *(const unsigned*)(src + 64);
        const bf16_t* sw = (const bf16_t*)(ws + WS_KW) + (size_t)t * 256; kx[k] = bf2f(sw[d]); ky[k] = bf2f(sw[d + 32]);
        vv[k] = *(const u32x2*)((const bf16_t*)(ws + WS_V) + (size_t)t * 256 + 4 * lane);
        cs64[k] = *(const f32x4*)((const float*)(ws + WS_ROPE64) + ((size_t)pos * 64 + 2 * i) * 2);
        cs32[k] = *(const f32x2*)((const float*)(ws + WS_ROPE32) + ((size_t)pos * 32 + d) * 2); }
#pragma unroll
    for (int k = 0; k < NB; ++k) {
        const int t = tk[k];
        {
            float x0 = bflo(u0[k]), x1 = bfhi(u0[k]), y0 = bflo(u1[k]), y1 = bfhi(u1[k]);
            float ss = x0 * x0 + x1 * x1 + y0 * y0 + y1 * y1;
            ss = x16_sum(row_sum(ss));
            const float rstd = rsqrtf(ss * (1.f / 128.f) + EPS);
            x0 *= rstd * ga.x; x1 *= rstd * ga.y; y0 *= rstd * gb.x; y1 *= rstd * gb.y;
            const f32x4 cs = cs64[k];
            const float ox0 = x0 * cs.x - y0 * cs.y, oy0 = y0 * cs.x + x0 * cs.y, ox1 = x1 * cs.z - y1 * cs.w, oy1 = y1 * cs.z + x1 * cs.w;
            unsigned char* d8 = ws + WS_K8 + (size_t)t * 256 + g * 128 + 2 * i;
            const int w0 = __builtin_amdgcn_cvt_pk_fp8_f32(ox0 * K8_SCALE, ox1 * K8_SCALE, 0, false), w1 = __builtin_amdgcn_cvt_pk_fp8_f32(oy0 * K8_SCALE, oy1 * K8_SCALE, 0, false);
            *(unsigned short*)d8 = (unsigned short)w0; *(unsigned short*)(d8 + 64) = (unsigned short)w1;
        }
        {
            int w = 0; w = __builtin_amdgcn_cvt_pk_fp8_f32(__builtin_amdgcn_fmed3f(bflo(vv[k].x) * V8_SCALE, -448.f, 448.f), __builtin_amdgcn_fmed3f(bfhi(vv[k].x) * V8_SCALE, -448.f, 448.f), w, false);
            w = __builtin_amdgcn_cvt_pk_fp8_f32(__builtin_amdgcn_fmed3f(bflo(vv[k].y) * V8_SCALE, -448.f, 448.f), __builtin_amdgcn_fmed3f(bfhi(vv[k].y) * V8_SCALE, -448.f, 448.f), w, true);
            *(unsigned*)(ws + WS_V8A + (size_t)t * 256 + 4 * lane) = (unsigned)w;
        }
        {
            float x = kx[k], y = ky[k];
            float ss = x * x + y * y;
            ss = x16_sum(row_sum(ss));
            const float rstd = rsqrtf(ss * (1.f / 64.f) + EPS);
            x *= rstd * gi0; y *= rstd * gi1;
            const f32x2 cs = cs32[k];
            const float ox = x * cs.x - y * cs.y, oy = y * cs.x + x * cs.y;
            bf16_t* dst = (bf16_t*)(ws + WS_KIN) + (size_t)(t >> 4) * 1024 + ((d >> 3) & 3) * 128 + (t & 15) * 8 + (d & 7);
            if (lane < 32) { dst[0] = (bf16_t)f2bf(ox); dst[512] = (bf16_t)f2bf(oy); }
        }
    }
}
__device__ __forceinline__ void mkprep_token(const Params& p, int m, int lane) {
    unsigned char* ws = p.ws;
    const int hd = lane >> 4, e0 = (lane & 15) * 16;
    const bf16_t* src = (const bf16_t*)(ws + WS_MKV) + (size_t)m * 2048 + hd * 256 + e0;
    float v[16]; unpack8(*(const u32x4*)src, v); unpack8(*(const u32x4*)(src + 8), v + 8);
    float ss = 0.f;
#pragma unroll
    for (int j = 0; j < 16; ++j) ss += v[j] * v[j];
    ss = row_sum(ss);
    const float rstd = rsqrtf(ss * (1.f / 256.f) + EPS);
#pragma unroll
    for (int j = 0; j < 16; ++j) v[j] *= rstd * ((const float*)(ws + WS_CONST))[C_MKN + e0 + j];
    bf16_t* dst = (bf16_t*)(ws + WS_MKN) + (size_t)m * 1024 + hd * 256 + e0;
    *(bf16x8*)dst = pack8(v); *(bf16x8*)(dst + 8) = pack8(v + 8);
}

constexpr int LRU_WLDS = 19456;
template <bool APPLY>
__device__ __forceinline__ void lru_item(const Params& p, LAS unsigned char* wlds, int item, int lane) {
    unsigned char* ws = p.ws;
    const int ck = item >> 4, nblk = item & 15, t0 = ck * 128, c0 = nblk * 64;
    const bool first = (ck & 31) == 0;
    const int row = lane & 15, grp = lane >> 4;
    const bf16_t* LX = (const bf16_t*)(ws + WS_LX);
#pragma unroll
    for (int i = 0; i < 17; ++i) { const int r = (lane >> 3) + 8 * i;
        if (r < 131) { u32x4 v = (u32x4){0u, 0u, 0u, 0u};
            if (!(first && r < 3)) v = *(const u32x4*)(LX + (size_t)(t0 - 3 + r) * 1024 + c0 + (lane & 7) * 8);
            *(LAS u32x4*)(wlds + r * 144 + (lane & 7) * 16) = v; } }
    LDS_WAIT();
    {
        const float w0 = ((const float*)(ws + WS_CONST))[C_CONVW + 0 * 1024 + c0 + lane], w1 = ((const float*)(ws + WS_CONST))[C_CONVW + 1 * 1024 + c0 + lane], w2 = ((const float*)(ws + WS_CONST))[C_CONVW + 2 * 1024 + c0 + lane], w3 = ((const float*)(ws + WS_CONST))[C_CONVW + 3 * 1024 + c0 + lane], cb = ((const float*)(ws + WS_CONST))[C_CONVB + c0 + lane];
        LAS bf16_t* col = (LAS bf16_t*)wlds + lane;
        float xa = bf2f(col[130 * 72]), xb = bf2f(col[129 * 72]), xcc = bf2f(col[128 * 72]);
#pragma unroll 8
        for (int t = 127; t >= 0; --t) { const float xd = bf2f(col[t * 72]);
            const float y = cb + w3 * xa + w2 * xb + w1 * xcc + w0 * xd;
            col[(t + 3) * 72] = (bf16_t)f2bf(y);
            xa = xb; xb = xcc; xcc = xd; }
    }
    LDS_WAIT();
    bf16x8 wa[4][2], wi[4][2];
    {
        const bf16_t* WA = (const bf16_t*)(ws + WS_WAT) + nblk * 4096; const bf16_t* WI = (const bf16_t*)(ws + WS_WIT) + nblk * 4096;
#pragma unroll
        for (int nt = 0; nt < 4; ++nt)
#pragma unroll
            for (int ks = 0; ks < 2; ++ks) { const int o = (16 * nt + row) * 64 + 32 * ks + 8 * grp; wa[nt][ks] = *(const bf16x8*)(WA + o); wi[nt][ks] = *(const bf16x8*)(WI + o); }
    }
    float ba[4], bi[4], sp[4], hc[4], atot[4];
#pragma unroll
    for (int nt = 0; nt < 4; ++nt) { const int d = c0 + 16 * nt + row; ba[nt] = ((const float*)(ws + WS_CONST))[C_LBA + d]; bi[nt] = ((const float*)(ws + WS_CONST))[C_LBI + d];
        sp[nt] = 8.0f * log1pf(__expf(-((const float*)(ws + WS_CONST))[C_LAM + d])); hc[nt] = 0.f; atot[nt] = 1.f; }
    if (APPLY) {
        const f32x2* SU = (const f32x2*)(ws + WS_LRUS);
        const int cb0 = ck & ~31;
        for (int j = cb0; j < ck; ++j) {
#pragma unroll
            for (int nt = 0; nt < 4; ++nt) { const f32x2 s = SU[(size_t)j * 1024 + c0 + 16 * nt + row]; hc[nt] = s.x * hc[nt] + s.y; } }
    }
    for (int mt = 0; mt < 8; ++mt) {
        const LAS unsigned char* arow = wlds + (16 * mt + 3 + row) * 144 + 16 * grp;
        const bf16x8 a0 = *(const LAS bf16x8*)arow, a1 = *(const LAS bf16x8*)(arow + 64);
#pragma unroll
        for (int nt = 0; nt < 4; ++nt) {
            f32x4 ca = (f32x4){0.f, 0.f, 0.f, 0.f}, ci = (f32x4){0.f, 0.f, 0.f, 0.f};
            ca = MFMA16(a0, wa[nt][0], ca); ca = MFMA16(a1, wa[nt][1], ca);
            ci = MFMA16(a0, wi[nt][0], ci); ci = MFMA16(a1, wi[nt][1], ci);
            LAS bf16_t* slot = (LAS bf16_t*)(wlds + (16 * mt + 3 + 4 * grp) * 144) + 16 * nt + row;
            float A = 1.f, U = 0.f, hl[4], ap[4];
#pragma unroll
            for (int reg = 0; reg < 4; ++reg) {
                const float r = sigmoidf_(ca[reg] + ba[nt]), ig = sigmoidf_(ci[reg] + bi[nt]);
                const float la = -r * sp[nt];
                const float a = __expf(la), mult = __builtin_amdgcn_sqrtf(fmaxf(1.0f - a * a, 0.f));
                const float u = mult * ig * bf2f(slot[reg * 72]);
                U = a * U + u; A *= a; hl[reg] = U; ap[reg] = A;
            }
            float Alo, Ahi, Ulo, Uhi;
            { const auto ra = __builtin_amdgcn_permlane16_swap(__float_as_uint(A), __float_as_uint(A), false, false); Alo = __uint_as_float(ra[0]); Ahi = __uint_as_float(ra[1]);
              const auto ru = __builtin_amdgcn_permlane16_swap(__float_as_uint(U), __float_as_uint(U), false, false); Ulo = __uint_as_float(ru[0]); Uhi = __uint_as_float(ru[1]); }
            const float Apair = Alo * Ahi, Upair = Ahi * Ulo + Uhi;
            float AP0, AP1, UP0, UP1;
            { const auto ra = __builtin_amdgcn_permlane32_swap(__float_as_uint(Apair), __float_as_uint(Apair), false, false); AP0 = __uint_as_float(ra[0]); AP1 = __uint_as_float(ra[1]);
              const auto ru = __builtin_amdgcn_permlane32_swap(__float_as_uint(Upair), __float_as_uint(Upair), false, false); UP0 = __uint_as_float(ru[0]); UP1 = __uint_as_float(ru[1]); }
            const float h0 = hc[nt], hmid = AP0 * h0 + UP0, h4 = AP1 * hmid + UP1;
            const bool oddg = (grp & 1) != 0, upperg = (grp & 2) != 0;
            const float hbase = upperg ? hmid : h0, pbase = upperg ? AP0 : 1.f;
            const float hin = oddg ? Alo * hbase + Ulo : hbase, pg = oddg ? pbase * Alo : pbase;
            if (!APPLY) {
                const float apre = atot[nt] * pg;
                unsigned* HA = (unsigned*)p.out;
                const unsigned ho = (unsigned)(t0 + 16 * mt + 4 * grp) * 1024u + (unsigned)(c0 + 16 * nt + row);
#pragma unroll
                for (int reg = 0; reg < 4; ++reg) HA[ho + 1024u * reg] = pk2(hl[reg] + ap[reg] * hin, apre * ap[reg]);
            }
            hc[nt] = h4; atot[nt] *= AP0 * AP1;
            if (APPLY) {
#pragma unroll
                for (int reg = 0; reg < 4; ++reg) slot[reg * 72] = (bf16_t)f2bf(hl[reg] + ap[reg] * hin);
            }
        }
    }
    if (!APPLY) {
        if (grp == 0) { f32x2* SU = (f32x2*)(ws + WS_LRUS);
#pragma unroll
            for (int nt = 0; nt < 4; ++nt) { f32x2 s; s.x = atot[nt]; s.y = hc[nt]; SU[(size_t)ck * 1024 + c0 + 16 * nt + row] = s; } }
    } else {
        LDS_WAIT();
        bf16_t* GG = (bf16_t*)(ws + WS_GG);
#pragma unroll 4
        for (int i = 0; i < 16; ++i) { const int r = (lane >> 3) + 8 * i;
            float hv[8], gv[8];
            unpack8(*(const LAS u32x4*)(wlds + (r + 3) * 144 + (lane & 7) * 16), hv);
            bf16_t* gp = GG + (size_t)(t0 + r) * 1024 + c0 + (lane & 7) * 8;
            unpack8(*(const u32x4*)gp, gv);
#pragma unroll
            for (int j = 0; j < 8; ++j) hv[j] *= gv[j];
            *(bf16x8*)gp = pack8(hv); }
    }
    LDS_WAIT();
}

__device__ __forceinline__ void lru_apply_item(const Params& p, int item, int lane) {
    unsigned char* ws = p.ws;
    const int ck = item >> 3, cq = item & 3, th = (item >> 2) & 1;
    const unsigned c = (unsigned)(cq * 256 + 4 * lane);
    float hin[4] = {0.f, 0.f, 0.f, 0.f};
    { const f32x4* SU = (const f32x4*)(ws + WS_LRUS);
      for (int j = ck & ~31; j < ck; ++j) { const f32x4 s0 = SU[((size_t)j * 1024 + c) >> 1], s1 = SU[(((size_t)j * 1024 + c) >> 1) + 1];
          hin[0] = s0.x * hin[0] + s0.y; hin[1] = s0.z * hin[1] + s0.w; hin[2] = s1.x * hin[2] + s1.y; hin[3] = s1.z * hin[3] + s1.w; } }
    const unsigned* HA = (const unsigned*)p.out; bf16_t* GG = (bf16_t*)(ws + WS_GG);
    const unsigned base = (unsigned)(ck * 128 + th * 64) * 1024u + c;
#pragma unroll 8
    for (int r = 0; r < 64; ++r) {
        const u32x4 ha = *(const u32x4*)(HA + base + 1024u * r); const u32x2 gg = *(const u32x2*)(GG + base + 1024u * r);
        const float y0 = (bflo(ha.x) + bfhi(ha.x) * hin[0]) * bflo(gg.x), y1 = (bflo(ha.y) + bfhi(ha.y) * hin[1]) * bfhi(gg.x);
        const float y2 = (bflo(ha.z) + bfhi(ha.z) * hin[2]) * bflo(gg.y), y3 = (bflo(ha.w) + bfhi(ha.w) * hin[3]) * bfhi(gg.y);
        u32x2 w; w.x = pk2(y0, y1); w.y = pk2(y2, y3);
        *(u32x2*)(GG + base + 1024u * r) = w;
    }
}

constexpr int SC_STRIDE = 4100;
constexpr int IDX_SC_BYTES = 8 * SC_STRIDE * 4;
constexpr int IDX_SEL_OFF = IDX_SC_BYTES;

constexpr int SEL_CAP = 64, SEL_HIST_B = 1056, SEL_CAND_B = 528, SEL_OUT_B = 528, SEL_WLDS = SEL_HIST_B + SEL_CAND_B + SEL_OUT_B;
constexpr int IDX_BQ_OFF = IDX_SEL_OFF + 8 * SEL_WLDS, IDX_BQ_BYTES = 8 * 1024 + 256;
__device__ __forceinline__ int sel_bin(float x, float lo, float scale) { int b = (int)((x - lo) * scale); b = b > 255 ? 255 : b; b = b < 0 ? 0 : b; return b; }
__device__ __forceinline__ unsigned lane_rank(unsigned long long mask) { return __builtin_amdgcn_mbcnt_hi((unsigned)(mask >> 32), __builtin_amdgcn_mbcnt_lo((unsigned)mask, 0u)); }
template <int N> struct SelIC { static constexpr int value = N; };
__device__ __forceinline__ void select_top256(LAS float* rowp, int n, bf16_t* out, LAS unsigned char* wl, int lane) {
    LAS unsigned* hist = (LAS unsigned*)wl; LAS u32x2* cand = (LAS u32x2*)(wl + SEL_HIST_B); LAS bf16_t* outl = (LAS bf16_t*)(wl + SEL_HIST_B + SEL_CAND_B);
    const int imax = (n + 255) >> 8;
    LAS float* myp = rowp + 4 * lane;
    if (n & 255) { const int i = n >> 8; f32x4 x = *(LAS f32x4*)(myp + 256 * i);
#pragma unroll
        for (int j = 0; j < 4; ++j) x[j] = (256 * i + 4 * lane + j) < n ? x[j] : -INFINITY;
        *(LAS f32x4*)(myp + 256 * i) = x; }
    float lmx, lmn;
    { const f32x4 x = *(LAS f32x4*)myp; lmx = fmaxf(fmaxf(x[0], x[1]), fmaxf(x[2], x[3])); lmn = fminf(fminf(x[0], x[1]), fminf(x[2], x[3])); }
    *(LAS u32x2*)(outl + 4 * lane) = (u32x2){0u, 0u};
    int need = 256, base = 0; unsigned m = 0, c0 = 0u, c1 = 0u;
#pragma unroll 1
    for (int round = 0; round < 6; ++round) {
        const float hi = wave_max(lmx), lo = wave_min(lmn);
        const float scale = (hi > lo) ? 255.0f / (hi - lo) : 0.f;
        *(LAS u32x4*)(hist + 4 * lane) = (u32x4){0u, 0u, 0u, 0u};
        LDS_WAIT();
        auto hpass = [&](int i0, auto chk) { constexpr bool CHK = decltype(chk)::value != 0;
            const f32x4 x = *(LAS f32x4*)(myp + 256 * i0);
#pragma unroll
            for (int j = 0; j < 4; ++j) { const int b = sel_bin(x[j], lo, scale); const int hb = (!CHK || x[j] > -INFINITY) ? b : 256; __hip_atomic_fetch_add(hist + hb, 1u, __ATOMIC_RELAXED, __HIP_MEMORY_SCOPE_WORKGROUP); } };
        if (round == 0) {
#pragma unroll 1
            for (int i0 = 0; i0 < imax - 1; ++i0) hpass(i0, SelIC<0>{});
            hpass(imax - 1, SelIC<1>{});
        } else {
#pragma unroll 1
            for (int i0 = 0; i0 < imax; ++i0) hpass(i0, SelIC<1>{});
        }
        LDS_WAIT();
        const u32x4 h4 = *(const LAS u32x4*)(hist + 4 * lane);
        const unsigned c4 = h4.x + h4.y + h4.z + h4.w;
        unsigned suf; { unsigned tot; const unsigned inc = wave_incl_scan(c4, lane, tot); suf = tot - inc + c4; }
        unsigned run = suf - c4; int fb = -1; unsigned fabove = 0, fm = 0;
        { const unsigned nd = (unsigned)need;
          if (run < nd && run + h4.w >= nd) { fb = 4 * lane + 3; fabove = run; fm = h4.w; } run += h4.w;
          if (run < nd && run + h4.z >= nd) { fb = 4 * lane + 2; fabove = run; fm = h4.z; } run += h4.z;
          if (run < nd && run + h4.y >= nd) { fb = 4 * lane + 1; fabove = run; fm = h4.y; } run += h4.y;
          if (run < nd && run + h4.x >= nd) { fb = 4 * lane + 0; fabove = run; fm = h4.x; } }
        const unsigned long long bal = __ballot(fb >= 0);
        const int src = __ffsll((long long)bal) - 1;
        const int srcu = __builtin_amdgcn_readfirstlane(src);
        const int bstar = __builtin_amdgcn_readlane(fb, srcu); const unsigned above = (unsigned)__builtin_amdgcn_readlane((int)fabove, srcu); m = (unsigned)__builtin_amdgcn_readlane((int)fm, srcu);
        unsigned s0 = 0u, s1 = 0u; c0 = 0u; c1 = 0u;
        float nmx = -INFINITY, nmn = INFINITY;
        auto epass = [&](int i0, auto chk, auto trk) { constexpr bool CHK = decltype(chk)::value != 0, TRACK = decltype(trk)::value != 0;
            f32x4 x = *(LAS f32x4*)(myp + 256 * i0);
            unsigned s4 = 0u, k4 = 0u;
#pragma unroll
            for (int j = 0; j < 4; ++j) { const float xv = x[j]; const int b = sel_bin(xv, lo, scale); const bool isc = !CHK || xv > -INFINITY; const bool sel = isc && b > bstar, kp = isc && b == bstar;
                s4 |= sel ? (1u << j) : 0u; k4 |= kp ? (1u << j) : 0u;
                if (TRACK) { const float y = kp ? xv : -INFINITY; x[j] = y; nmx = fmaxf(nmx, y); nmn = fminf(nmn, kp ? y : INFINITY); } }
            if (TRACK) *(LAS f32x4*)(myp + 256 * i0) = x;
            const unsigned sh = (unsigned)(4 * i0) & 31u;
            if (i0 < 8) { s0 |= s4 << sh; c0 |= k4 << sh; } else { s1 |= s4 << sh; c1 |= k4 << sh; } };
        if (m <= (unsigned)SEL_CAP) {
            if (round == 0) {
#pragma unroll 1
                for (int i0 = 0; i0 < imax - 1; ++i0) epass(i0, SelIC<0>{}, SelIC<0>{});
                epass(imax - 1, SelIC<1>{}, SelIC<0>{});
            } else {
#pragma unroll 1
                for (int i0 = 0; i0 < imax; ++i0) epass(i0, SelIC<1>{}, SelIC<0>{});
            }
        } else {
#pragma unroll 1
            for (int i0 = 0; i0 < imax; ++i0) epass(i0, SelIC<1>{}, SelIC<1>{});
        }
        {
            unsigned off = (unsigned)base + wave_excl_scan((unsigned)(__popc(s0) + __popc(s1)), lane);
            while (s0) { const int k = __ffs((int)s0) - 1; s0 &= s0 - 1u; outl[off++] = (bf16_t)(256 * (k >> 2) + 4 * lane + (k & 3)); }
            while (s1) { const int k = __ffs((int)s1) - 1; s1 &= s1 - 1u; outl[off++] = (bf16_t)(256 * (8 + (k >> 2)) + 4 * lane + (k & 3)); }
        }
        base += (int)above; need -= (int)above; lmx = nmx; lmn = nmn;
        if (m <= (unsigned)SEL_CAP) break;
        if (!(wave_max(nmx) > wave_min(nmn))) break;
    }
    {
        unsigned pos = wave_excl_scan((unsigned)(__popc(c0) + __popc(c1)), lane);
        while (c0) { const int k = __ffs((int)c0) - 1; c0 &= c0 - 1u; u32x2 c; c.x = __float_as_uint(myp[256 * (k >> 2) + (k & 3)]); c.y = (unsigned)(256 * (k >> 2) + 4 * lane + (k & 3));
            cand[pos < (unsigned)SEL_CAP ? pos : (unsigned)SEL_CAP] = c; ++pos; }
        while (c1) { const int k = __ffs((int)c1) - 1; c1 &= c1 - 1u; u32x2 c; c.x = __float_as_uint(myp[256 * (8 + (k >> 2)) + (k & 3)]); c.y = (unsigned)(256 * (8 + (k >> 2)) + 4 * lane + (k & 3));
            cand[pos < (unsigned)SEL_CAP ? pos : (unsigned)SEL_CAP] = c; ++pos; }
    }
    LDS_WAIT();
    if (m <= (unsigned)SEL_CAP) {
        for (unsigned ci = lane; ci < m; ci += 64) {
            const u32x2 my = cand[ci]; const float mv = __uint_as_float(my.x); int rank = 0;
            for (unsigned j = 0; j < m; ++j) { const u32x2 o = cand[j]; const float ov = __uint_as_float(o.x); rank += (ov > mv || (ov == mv && o.y < my.y)) ? 1 : 0; }
            if (rank < need) outl[base + rank] = (bf16_t)my.y;
        }
    } else {
        for (unsigned ci = lane; ci < (unsigned)SEL_CAP; ci += 64) if ((int)ci < need) outl[base + ci] = (bf16_t)cand[ci].y;
    }
    LDS_WAIT();
    if (out) *(u32x2*)(out + 4 * lane) = *(const LAS u32x2*)(outl + 4 * lane);
    LDS_WAIT();
}

static_assert(IDX_BQ_OFF + IDX_BQ_BYTES <= LDS_BYTES, "indexer LDS");
__device__ __forceinline__ float dpp_xor8_add(float x) {
    return x + __builtin_bit_cast(float, __builtin_amdgcn_update_dpp(0, __builtin_bit_cast(int, x), 0x128, 0xf, 0xf, true));
}
__device__ __forceinline__ void indexer_prefetch(const Params& p, int b, int p0, int lane, int hp, u32x4 (&qraw)[2], f32x4 (&cs)[4], float (&wraw)[4]) {
    unsigned char* ws = p.ws;
    const int q = lane & 7, hsel = (lane >> 3) & 1, grp = lane >> 4, tq = b * SEQ + p0 + q;
    const float* csp = (const float*)(ws + WS_ROPE32) + ((size_t)(p0 + q) * 32 + 8 * grp) * 2;
#pragma unroll
    for (int j4 = 0; j4 < 4; ++j4) cs[j4] = *(const f32x4*)(csp + 4 * j4);
    { const bf16_t* src = (const bf16_t*)(ws + WS_QI) + (size_t)tq * 512 + (2 * hp + hsel) * 64 + 8 * grp;
      qraw[0] = *(const u32x4*)src; qraw[1] = *(const u32x4*)(src + 32); }
#pragma unroll
    for (int h2 = 0; h2 < 4; ++h2) wraw[h2] = bf2f(((const bf16_t*)(ws + WS_KW))[(size_t)tq * 256 + 64 + 2 * h2 + hsel]);
}
__device__ __forceinline__ void indexer_build_frag(LAS unsigned char* bqb, int wave, int lane, const u32x4 (&qraw)[2], const f32x4 (&cs)[4]) {
    float c[8], s[8], x0[8], x1[8], o[8];
#pragma unroll
    for (int j4 = 0; j4 < 4; ++j4) { const f32x4 t = cs[j4]; c[2 * j4] = t.x; s[2 * j4] = t.y; c[2 * j4 + 1] = t.z; s[2 * j4 + 1] = t.w; }
    unpack8(qraw[0], x0); unpack8(qraw[1], x1);
    if (wave & 1) {
#pragma unroll
        for (int j = 0; j < 8; ++j) o[j] = (x1[j] * c[j] + x0[j] * s[j]) * 0.125f;
    } else {
#pragma unroll
        for (int j = 0; j < 8; ++j) o[j] = (x0[j] * c[j] - x1[j] * s[j]) * 0.125f;
    }
    *(LAS bf16x8*)(bqb + wave * 1024 + lane * 16) = pack8(o);
}
constexpr size_t WS_U8 = WS_IDX, WS_UVINV = 58 * MiB;
__device__ __forceinline__ size_t v8_slice_off(int s) { return (size_t)(s < 4 ? 68 + 2 * s : (s < 6 ? 28 + 2 * s : 32 + 2 * s)) * MiB; }
__device__ __forceinline__ void quant_row_load(const Params& p, f32x4 (&v)[4], int r, int lane) {
    const f32x4* s4 = (const f32x4*)(((r >> 14) ? p.peer_v : p.peer_u) + (size_t)(r & 16383) * 1024) + 4 * lane;
#pragma unroll
    for (int j = 0; j < 4; ++j) v[j] = s4[j];
}
__device__ __forceinline__ void quant_row_regs(const Params& p, f32x4 (&v)[4], int r, int lane) {
    unsigned char* ws = p.ws;
    const int which = r >> 14, rr = r & 16383; float am = 0.f;
#pragma unroll
    for (int j = 0; j < 4; ++j) { if (!which) v[j] *= ((const f32x4*)(((const float*)(ws + WS_CONST)) + C_NFFN))[4 * lane + j]; am = fmaxf(am, fmaxf(fmaxf(fabsf(v[j].x), fabsf(v[j].y)), fmaxf(fabsf(v[j].z), fabsf(v[j].w)))); }
    am = wave_max(am);
    const float sc = am > 0.f ? 240.0f / am : 1.0f;
    u32x4 o;
#pragma unroll
    for (int j = 0; j < 4; ++j) { int w = 0; w = __builtin_amdgcn_cvt_pk_fp8_f32(v[j].x * sc, v[j].y * sc, w, false); w = __builtin_amdgcn_cvt_pk_fp8_f32(v[j].z * sc, v[j].w * sc, w, true); o[j] = (unsigned)w; }
    const size_t sbase = which ? v8_slice_off(lane >> 3) : WS_U8 + (size_t)(lane >> 3) * 2097152;
    *(u32x4*)(ws + sbase + (size_t)rr * 128 + 16 * (lane & 7)) = o;
    if (lane == 0) ((float*)(ws + WS_UVINV))[2 * rr + which] = am > 0.f ? am / 240.0f : 1.0f;
}
template <int DRY> __device__ __forceinline__ void attn_item(const Params& p, LAS unsigned char* wlds, int tq, int g, int lane, const u32x4 (&idx_in)[4], const u32x4 (&q_in)[4]);
__device__ __forceinline__ void attn_q_prefetch(const Params& p, int tq, int g, int lane, u32x4 (&q_o)[4]) {
    const int row = lane & 15, grp = lane >> 4;
    const bf16_t* qp = (const bf16_t*)(p.ws + WS_Q) + (size_t)tq * 1024 + g * 512 + (row & 3) * 128 + 16 * grp;
    const u32x4 z = (u32x4){0u, 0u, 0u, 0u};
    const u32x4 a = *(const u32x4*)qp, b2 = *(const u32x4*)(qp + 8), c = *(const u32x4*)(qp + 64), d = *(const u32x4*)(qp + 72);
    q_o[0] = row < 4 ? a : z; q_o[1] = row < 4 ? b2 : z; q_o[2] = row < 4 ? c : z; q_o[3] = row < 4 ? d : z;
}
template <int MODE> __device__ __forceinline__ void indexer_phase(const Params& p, LAS unsigned char* lds, int bid, int G, int lane, int wave) {
    unsigned char* ws = p.ws;
    LAS float* SC = (LAS float*)lds;
    int pi2 = 2 * bid, qk = 0;
    const int aitem = bid * NWAVES + wave; const bool ado = aitem < 2048;
    f32x4* ahp = (f32x4*)(ws + WS_SSQ) + (size_t)aitem * 64;
    if (ado) { float ahin[4] = {0.f, 0.f, 0.f, 0.f}; const int ck = aitem >> 3, cq = aitem & 3; const unsigned c = (unsigned)(cq * 256 + 4 * lane);
        const f32x4* SU = (const f32x4*)(ws + WS_LRUS);
        for (int j = ck & ~31; j < ck; ++j) { const f32x4 s0 = SU[((size_t)j * 1024 + c) >> 1], s1 = SU[(((size_t)j * 1024 + c) >> 1) + 1];
            ahin[0] = s0.x * ahin[0] + s0.y; ahin[1] = s0.z * ahin[1] + s0.w; ahin[2] = s1.x * ahin[2] + s1.y; ahin[3] = s1.z * ahin[3] + s1.w; }
        ahp[lane] = (f32x4){ahin[0], ahin[1], ahin[2], ahin[3]}; }
#define IDX_ABASE(LN) ((unsigned)((aitem >> 3) * 128 + ((aitem >> 2) & 1) * 64) * 1024u + (unsigned)((aitem & 3) * 256 + 4 * (LN)))
    LAS unsigned char* bqb = lds + IDX_BQ_OFF;
    u32x4 nqraw[2]; f32x4 ncs[4]; float nwraw[4];
    if (pi2 < 4096) { const int pi = pi2 >> 1; indexer_prefetch(p, pi >> 8, (pi2 & 1) ? 8 * (511 - (pi & 255)) : 8 * (pi & 255), lane, wave >> 1, nqraw, ncs, nwraw); }
    else { nqraw[0] = nqraw[1] = (u32x4){0u, 0u, 0u, 0u}; for (int j = 0; j < 4; ++j) { ncs[j] = (f32x4){0.f, 0.f, 0.f, 0.f}; nwraw[j] = 0.f; } }
    indexer_build_frag(bqb, wave, lane, nqraw, ncs);
    if (wave == 0 && lane < 16) {
#pragma unroll
        for (int h2 = 0; h2 < 4; ++h2) ((LAS float*)(bqb + 8192))[16 * h2 + lane] = nwraw[h2]; }
    __syncthreads();
#pragma unroll 1
    while (pi2 < 4096) {
        const int pi = pi2 >> 1, b = pi >> 8, pr = pi & 255, p0 = (pi2 & 1) ? 8 * (511 - pr) : 8 * pr, tq0 = b * SEQ + p0;
        const int nxt = pi2 + ((pi2 & 1) ? 2 * G - 1 : 1);
        lane = fresh_lane();
        const int q = lane & 7, grp = lane >> 4, row = lane & 15;
        bf16x8 bq[4][2]; float w[4];
#pragma unroll
        for (int hp = 0; hp < 4; ++hp) { bq[hp][0] = *(const LAS bf16x8*)(bqb + (2 * hp) * 1024 + lane * 16); bq[hp][1] = *(const LAS bf16x8*)(bqb + (2 * hp + 1) * 1024 + lane * 16); w[hp] = ((const LAS float*)(bqb + 8192))[16 * hp + (lane & 15)] * 0.35355339059327373f; }
        const int nkt = (p0 >> 4) + 1;
        const bf16_t* kbase = (const bf16_t*)(ws + WS_KIN) + (size_t)(b * SEQ) * 64 + grp * 128 + row * 8;
        bf16x8 n0[4], n1[4];
#define IDX_TLOAD(KT0) do { _Pragma("unroll") for (int u = 0; u < 4; ++u) { const int kt = (KT0) + 8 * u < nkt ? (KT0) + 8 * u : wave; const bf16_t* kp = kbase + (size_t)kt * 1024; \
            n0[u] = *(const bf16x8*)kp; n1[u] = *(const bf16x8*)(kp + 512); } } while (0)
        for (int kt0 = wave; MODE != 2 && kt0 < nkt; kt0 += 32) {
            bf16x8 a0[4], a1[4];
#pragma unroll
            IDX_TLOAD(kt0);
#pragma unroll
            for (int u = 0; u < 4; ++u) { a0[u] = n0[u]; a1[u] = n1[u]; }
#pragma unroll
            for (int u = 0; u < 4; ++u) {
                const int kt = kt0 + 8 * u;
                if (kt >= nkt) break;
                f32x4 c[4];
#pragma unroll
                for (int hp = 0; hp < 4; ++hp) c[hp] = MFMA16(a0[u], bq[hp][0], ((f32x4){0.f, 0.f, 0.f, 0.f}));
#pragma unroll
                for (int hp = 0; hp < 4; ++hp) c[hp] = MFMA16(a1[u], bq[hp][1], c[hp]);
                __builtin_amdgcn_sched_barrier(0);
                f32x4 acc = (f32x4){0.f, 0.f, 0.f, 0.f};
#pragma unroll
                for (int hp = 0; hp < 4; ++hp)
#pragma unroll
                    for (int r = 0; r < 4; ++r) { const float cf = c[hp][r]; const int cb = __float_as_int(cf); acc[r] += __int_as_float(cb > 0 ? cb : 0) * w[hp]; }
#pragma unroll
                for (int r = 0; r < 4; ++r) { acc[r] = dpp_xor8_add(acc[r]); if (16 * kt + 4 * grp + r > p0 + q) acc[r] = -INFINITY; }
                if (row < 8 && kt < nkt) *(LAS f32x4*)(SC + q * SC_STRIDE + 16 * kt + 4 * grp) = acc;
            }
        }
#undef IDX_TLOAD
        if (nxt < 4096) { const int npi = nxt >> 1; indexer_prefetch(p, npi >> 8, (nxt & 1) ? 8 * (511 - (npi & 255)) : 8 * (npi & 255), fresh_lane(), wave >> 1, nqraw, ncs, nwraw); }
        __syncthreads();
        if (nxt < 4096) { indexer_build_frag(bqb, wave, lane, nqraw, ncs);
            if (wave == 0 && lane < 16) {
#pragma unroll
                for (int h2 = 0; h2 < 4; ++h2) ((LAS float*)(bqb + 8192))[16 * h2 + lane] = nwraw[h2]; } }
        lane = fresh_lane();
        {
            const int pos = p0 + wave, n = pos + 1;
            u32x4 qg0[4], qg1[4];
            attn_q_prefetch(p, tq0 + wave, 0, lane, qg0); attn_q_prefetch(p, tq0 + wave, 1, lane, qg1);
            u32x4 aha[4]; u32x2 agg[4]; f32x4 ahv = (f32x4){0.f, 0.f, 0.f, 0.f}; const bool adoi = ado && qk < 16; const unsigned abase = IDX_ABASE(lane);
            if (adoi) { ahv = ahp[lane];
#pragma unroll
                for (int rr = 0; rr < 4; ++rr) { const unsigned o = abase + 1024u * (unsigned)(4 * qk + rr); aha[rr] = *(const u32x4*)((const unsigned*)p.out + o); agg[rr] = *(const u32x2*)((const bf16_t*)(ws + WS_GG) + o); } }
            f32x4 trow[4]; const int trr = (bid * NWAVES + wave) + qk * (G * NWAVES);
            const bool tdo = trr < 32768; if (tdo) quant_row_load(p, trow, trr, lane);
            ++qk;
            LAS unsigned char* wl = lds + IDX_SEL_OFF + wave * SEL_WLDS;
            LAS bf16_t* outl = (LAS bf16_t*)(wl + SEL_HIST_B + SEL_CAND_B);
            if (n <= 256) { for (int i = lane; i < 256; i += 64) outl[i] = (bf16_t)(i < n ? i : 0); LDS_WAIT(); }
            else select_top256(SC + wave * SC_STRIDE, n, (bf16_t*)nullptr, wl, lane);
            if (tdo) quant_row_regs(p, trow, trr, lane);
            if (adoi) {
#pragma unroll
                for (int rr = 0; rr < 4; ++rr) { const unsigned o = abase + 1024u * (unsigned)(4 * (qk - 1) + rr); const u32x4 ha = aha[rr]; const u32x2 gg = agg[rr];
                    const float y0 = (bflo(ha.x) + bfhi(ha.x) * ahv[0]) * bflo(gg.x), y1 = (bflo(ha.y) + bfhi(ha.y) * ahv[1]) * bfhi(gg.x);
                    const float y2 = (bflo(ha.z) + bfhi(ha.z) * ahv[2]) * bflo(gg.y), y3 = (bflo(ha.w) + bfhi(ha.w) * ahv[3]) * bfhi(gg.y);
                    u32x2 w; w.x = pk2(y0, y1); w.y = pk2(y2, y3);
                    *(u32x2*)((bf16_t*)(ws + WS_GG) + o) = w; } }
            LAS unsigned char* awl = (LAS unsigned char*)(SC + wave * SC_STRIDE);
            LAS unsigned char* qbuf = awl + 13824 + ((lane & 3) * 4 + (lane >> 4)) * 64;
            if ((lane & 15) < 4) {
#pragma unroll
                for (int k = 0; k < 4; ++k) { *(LAS u32x4*)(qbuf + 16 * k) = qg0[k]; *(LAS u32x4*)(qbuf + 1024 + 16 * k) = qg1[k]; } }
            LDS_WAIT();
#pragma unroll 1
            for (int g = 0; g < 2; ++g) {
                u32x4 cq[4], ix[4]; const u32x4 z = (u32x4){0u, 0u, 0u, 0u};
                const int ln = fresh_lane();
#pragma unroll
                for (int r = 0; r < 4; ++r) ix[r] = *(const LAS u32x4*)((const LAS unsigned char*)outl + 64 * (ln >> 3) + 16 * r);
                const LAS unsigned char* qb2 = awl + 13824 + ((ln & 3) * 4 + (ln >> 4)) * 64 + g * 1024;
#pragma unroll
                for (int k = 0; k < 4; ++k) { const u32x4 v = *(const LAS u32x4*)(qb2 + 16 * k); cq[k] = (ln & 15) < 4 ? v : z; }
                attn_item<0>(p, awl, tq0 + wave, g, fresh_lane(), ix, cq);
            }
        }
        __syncthreads();
        pi2 = nxt;
    }
    if (ado) { const int ln = fresh_lane(); const unsigned abase = IDX_ABASE(ln); const f32x4 ahv = ahp[ln]; const float ahin[4] = {ahv[0], ahv[1], ahv[2], ahv[3]};
        for (int r = 4 * (qk < 16 ? qk : 16); r < 64; ++r) { const unsigned o = abase + 1024u * (unsigned)r; const u32x4 ha = *(const u32x4*)((const unsigned*)p.out + o); const u32x2 gg = *(const u32x2*)((const bf16_t*)(ws + WS_GG) + o);
            const float y0 = (bflo(ha.x) + bfhi(ha.x) * ahin[0]) * bflo(gg.x), y1 = (bflo(ha.y) + bfhi(ha.y) * ahin[1]) * bfhi(gg.x);
            const float y2 = (bflo(ha.z) + bfhi(ha.z) * ahin[2]) * bflo(gg.y), y3 = (bflo(ha.w) + bfhi(ha.w) * ahin[3]) * bfhi(gg.y);
            u32x2 w; w.x = pk2(y0, y1); w.y = pk2(y2, y3); *(u32x2*)((bf16_t*)(ws + WS_GG) + o) = w; } }
    for (;; ++qk) { const int r = (bid * NWAVES + wave) + qk * (G * NWAVES); if (r >= 32768) break;
        f32x4 trow[4]; quant_row_load(p, trow, r, fresh_lane()); quant_row_regs(p, trow, r, fresh_lane()); }
#undef IDX_ABASE
}

constexpr int ATT_RS = 288;
constexpr int ATT_KOFF = 32 * 144;
constexpr int ATT_WLDS = 64 * ATT_RS;
typedef short s16x4 __attribute__((ext_vector_type(4)));
typedef int i32x2v __attribute__((ext_vector_type(2)));
__device__ __forceinline__ s16x4 lds_tr16(const LAS unsigned char* pp) { return __builtin_amdgcn_ds_read_tr16_b64_v4i16((LAS s16x4*)pp); }
template <int DRY> __device__ __forceinline__ void attn_item(const Params& p, LAS unsigned char* wlds, int tq, int g, int lane, const u32x4 (&idx_in)[4], const u32x4 (&q_in)[4]) {
    unsigned char* ws = p.ws;
    const int b = tq >> 12, pos = tq & (SEQ - 1), cnt = pos + 1 < 256 ? pos + 1 : 256;
    const int row = lane & 15, grp = lane >> 4;
    bf16_t* Qrow = (bf16_t*)(ws + WS_Q) + (size_t)tq * 1024 + g * 512;
#define ATT_IDX(j) (((idx_in[(j) >> 3][((j) >> 1) & 3] >> (16 * ((j) & 1))) & 0xffffu) & (DRY ? (unsigned)(DRY - 1) : 0xffffu))
    long qf8[4]; float sfix;
    {
        float qa[16], qb[16]; float ss = 0.f;
        unpack8(q_in[0], qa); unpack8(q_in[1], qa + 8); unpack8(q_in[2], qb); unpack8(q_in[3], qb + 8);
#pragma unroll
        for (int j = 0; j < 16; ++j) ss += qa[j] * qa[j] + qb[j] * qb[j];
        ss = x32_sum(x16_sum(ss));
        const float rstd = rsqrtf(ss * (1.f / 128.f) + EPS) * 0.08838834764831845f;
        const float* gn = ((const float*)(ws + WS_CONST)) + C_QN + 16 * grp;
        const float* cs = (const float*)(ws + WS_ROPE64) + ((size_t)pos * 64 + 16 * grp) * 2;
        float am = 0.f;
#pragma unroll
        for (int j4 = 0; j4 < 4; ++j4) { const f32x4 ga = *(const f32x4*)(gn + 4 * j4), gb = *(const f32x4*)(gn + 64 + 4 * j4); const f32x4 t0 = *(const f32x4*)(cs + 8 * j4), t1 = *(const f32x4*)(cs + 8 * j4 + 4);
            const float gav[4] = {ga.x, ga.y, ga.z, ga.w}, gbv[4] = {gb.x, gb.y, gb.z, gb.w}, cv[4] = {t0.x, t0.z, t1.x, t1.z}, sv[4] = {t0.y, t0.w, t1.y, t1.w};
#pragma unroll
            for (int u = 0; u < 4; ++u) { const int j = 4 * j4 + u; const float a = qa[j] * rstd * gav[u], bb = qb[j] * rstd * gbv[u];
                qa[j] = a * cv[u] - bb * sv[u]; qb[j] = bb * cv[u] + a * sv[u]; am = fmaxf(am, fmaxf(fabsf(qa[j]), fabsf(qb[j]))); } }
        am = x32_max(x16_max(am));
        const float sc = am > 0.f ? 240.0f / am : 1.0f; sfix = (am > 0.f ? am * (1.0f / 240.0f) : 1.0f) * (1.4426950408889634f / K8_SCALE);
#pragma unroll
        for (int m = 0; m < 4; ++m) { const float* v = (m < 2 ? qa : qb) + 8 * (m & 1); int lo = 0, hi = 0;
            lo = __builtin_amdgcn_cvt_pk_fp8_f32(v[0] * sc, v[1] * sc, lo, false); lo = __builtin_amdgcn_cvt_pk_fp8_f32(v[2] * sc, v[3] * sc, lo, true);
            hi = __builtin_amdgcn_cvt_pk_fp8_f32(v[4] * sc, v[5] * sc, hi, false); hi = __builtin_amdgcn_cvt_pk_fp8_f32(v[6] * sc, v[7] * sc, hi, true);
            qf8[m] = (long)(((unsigned long long)(unsigned)hi << 32) | (unsigned long long)(unsigned)lo); }
    }
    f32x4 S[16];
    {
        const unsigned char* Kb = ws + WS_K8; const unsigned koff = (unsigned)b * (SEQ * 256u) + g * 128u + 16u * (lane & 7);
        LAS unsigned char* kst = wlds + ATT_KOFF + (lane >> 3) * 144 + 16 * (lane & 7);
        const LAS unsigned char* kfr = wlds + ATT_KOFF + row * 144 + 16 * grp;
        u32x4 kr[4][2];
#define ATT_KLOAD(BUF, KT) do { _Pragma("unroll") for (int i = 0; i < 2; ++i) { const int slot = 16 * (KT) + 8 * i; \
            const unsigned e = ATT_IDX(slot >> 3); kr[BUF][i] = *(const u32x4*)(Kb + (e * 256u + koff)); } } while (0)
        ATT_KLOAD(0, 0); ATT_KLOAD(1, 1); ATT_KLOAD(2, 2); ATT_KLOAD(3, 3);
#pragma unroll
        for (int kt = 0; kt < 16; ++kt) {
            const int buf = kt & 3;
#pragma unroll
            for (int i = 0; i < 2; ++i) *(LAS u32x4*)(kst + buf * (16 * 144) + 8 * i * 144) = kr[buf][i];
            if (kt + 4 < 16) ATT_KLOAD(buf, kt + 4);
            LDS_WAIT();
            const u32x4 r0 = *(const LAS u32x4*)(kfr + buf * (16 * 144)), r1 = *(const LAS u32x4*)(kfr + buf * (16 * 144) + 64);
            f32x4 acc = (f32x4){0.f, 0.f, 0.f, 0.f};
            acc = __builtin_amdgcn_mfma_f32_16x16x32_fp8_fp8((long)(((unsigned long long)r0.y << 32) | r0.x), qf8[0], acc, 0, 0, 0);
            acc = __builtin_amdgcn_mfma_f32_16x16x32_fp8_fp8((long)(((unsigned long long)r0.w << 32) | r0.z), qf8[1], acc, 0, 0, 0);
            acc = __builtin_amdgcn_mfma_f32_16x16x32_fp8_fp8((long)(((unsigned long long)r1.y << 32) | r1.x), qf8[2], acc, 0, 0, 0);
            acc = __builtin_amdgcn_mfma_f32_16x16x32_fp8_fp8((long)(((unsigned long long)r1.w << 32) | r1.z), qf8[3], acc, 0, 0, 0);
            S[kt] = acc * sfix;
            __builtin_amdgcn_sched_barrier(0);
        }
#undef ATT_KLOAD
    }
    f32x4 O[8];
#pragma unroll
    for (int mt = 0; mt < 8; ++mt) O[mt] = (f32x4){0.f, 0.f, 0.f, 0.f};
    const unsigned char* Vb = ws + WS_V8A; const unsigned voff = (unsigned)b * (SEQ * 256u) + g * 128u + 16u * (lane & 7);
    const int r8 = lane >> 3;
    LAS unsigned char* wst = wlds + (8 * (r8 >> 2) + (r8 & 3)) * 144 + 16 * (lane & 7);
    const LAS unsigned char* trp = wlds + (8 * grp + (row >> 1)) * 144 + 8 * (row & 1);
    u32x4 vr[4];
#define ATT_VLOAD(RD) do { _Pragma("unroll") for (int i = 0; i < 4; ++i) { const int slot = 32 * (RD) + 8 * i; \
        const unsigned e = ATT_IDX(slot >> 3); vr[i] = *(const u32x4*)(Vb + (e * 256u + voff)); } } while (0)
    ATT_VLOAD(0);
    __builtin_amdgcn_sched_barrier(0);
    long pf[8]; float pinv;
    {
        if (cnt < 256) {
#pragma unroll
            for (int kt = 0; kt < 16; ++kt)
#pragma unroll
                for (int r = 0; r < 4; ++r) { const int s = 16 * kt + 4 * grp + r; if (32 * (s & 7) + (s >> 3) >= cnt) S[kt][r] = -INFINITY; }
        }
        float mx = -INFINITY;
#pragma unroll
        for (int kt = 0; kt < 16; ++kt) mx = fmaxf(mx, fmaxf(fmaxf(S[kt][0], S[kt][1]), fmaxf(S[kt][2], S[kt][3])));
        mx = x32_max(x16_max(mx));
        float sum = 0.f;
#pragma unroll
        for (int kt = 0; kt < 16; ++kt)
#pragma unroll
            for (int r = 0; r < 4; ++r) { const float ev = __builtin_amdgcn_exp2f(S[kt][r] - mx); S[kt][r] = ev; sum += ev; }
        sum = x32_sum(x16_sum(sum));
        pinv = frcp(sum);
#pragma unroll
        for (int ks = 0; ks < 8; ++ks) { int lo = 0, hi = 0;
            lo = __builtin_amdgcn_cvt_pk_fp8_f32(S[2 * ks][0] * P8_SCALE, S[2 * ks][1] * P8_SCALE, lo, false); lo = __builtin_amdgcn_cvt_pk_fp8_f32(S[2 * ks][2] * P8_SCALE, S[2 * ks][3] * P8_SCALE, lo, true);
            hi = __builtin_amdgcn_cvt_pk_fp8_f32(S[2 * ks + 1][0] * P8_SCALE, S[2 * ks + 1][1] * P8_SCALE, hi, false); hi = __builtin_amdgcn_cvt_pk_fp8_f32(S[2 * ks + 1][2] * P8_SCALE, S[2 * ks + 1][3] * P8_SCALE, hi, true);
            pf[ks] = (long)(((unsigned long long)(unsigned)hi << 32) | (unsigned long long)(unsigned)lo); }
    }
#pragma unroll
    for (int rd = 0; rd < 8; ++rd) {
#pragma unroll
        for (int i = 0; i < 4; ++i) *(LAS u32x4*)(wst + (16 * (i & 1) + 4 * (i >> 1)) * 144) = vr[i];
        if (rd < 7) ATT_VLOAD(rd + 1);
        LDS_WAIT();
#pragma unroll
        for (int mt = 0; mt < 8; ++mt) {
            const i32x2v t = __builtin_amdgcn_ds_read_tr8_b64_v2i32((LAS i32x2v*)(trp + 16 * mt));
            O[mt] = __builtin_amdgcn_mfma_f32_16x16x32_fp8_fp8((long)(((unsigned long long)(unsigned)t.y << 32) | (unsigned long long)(unsigned)t.x), pf[rd], O[mt], 0, 0, 0);
        }
        LDS_WAIT();
    }
#undef ATT_VLOAD
#undef ATT_IDX
    pinv *= 1.0f / (P8_SCALE * V8_SCALE);
    if (row < 4 && (!DRY || O[0][0] == 12345.678f)) {
        bf16_t* op = Qrow + row * 128 + 4 * grp;
#pragma unroll
        for (int mt = 0; mt < 8; ++mt) { u32x2 w; w.x = pk2(O[mt][0] * pinv, O[mt][1] * pinv); w.y = pk2(O[mt][2] * pinv, O[mt][3] * pinv); *(u32x2*)(op + 16 * mt) = w; }
    }
}
__device__ __forceinline__ void attn_prefetch(const Params& p, int tq, int g, int lane, u32x4 (&idx_o)[4], u32x4 (&q_o)[4]) {
    const bf16_t* ip = (const bf16_t*)(p.ws + WS_IDX) + (size_t)tq * 256;
#pragma unroll
    for (int r = 0; r < 4; ++r) idx_o[r] = *((const u32x4*)(ip + 32 * (lane >> 3)) + r);
    const int row = lane & 15, grp = lane >> 4;
    const bf16_t* qp = (const bf16_t*)(p.ws + WS_Q) + (size_t)tq * 1024 + g * 512 + (row & 3) * 128 + 16 * grp;
    const u32x4 z = (u32x4){0u, 0u, 0u, 0u};
    const u32x4 a = *(const u32x4*)qp, b2 = *(const u32x4*)(qp + 8), c = *(const u32x4*)(qp + 64), d = *(const u32x4*)(qp + 72);
    q_o[0] = row < 4 ? a : z; q_o[1] = row < 4 ? b2 : z; q_o[2] = row < 4 ? c : z; q_o[3] = row < 4 ? d : z;
}
template <int DRY> __device__ __forceinline__ void attn_phase(const Params& p, LAS unsigned char* wlds, int nc, int cls, int cw, int ncw, int lane) {
    const int nbat = (NBATCH - cls + nc - 1) / nc, total = nbat * 2 * SEQ;
    if (cw >= total) return;
    u32x4 nidx[4]; u32x4 nq[4];
    { const int f = cw; attn_prefetch(p, (cls + nc * (f >> 13)) * SEQ + (f & (SEQ - 1)), (f >> 12) & 1, lane, nidx, nq); }
    for (int f = cw; f < total; f += ncw) {
        u32x4 cidx[4]; u32x4 cq[4];
#pragma unroll
        for (int r = 0; r < 4; ++r) { cidx[r] = nidx[r]; cq[r] = nq[r]; }
        const int fn = f + ncw < total ? f + ncw : f;
        attn_prefetch(p, (cls + nc * (fn >> 13)) * SEQ + (fn & (SEQ - 1)), (fn >> 12) & 1, lane, nidx, nq);
        attn_item<DRY>(p, wlds, (cls + nc * (f >> 13)) * SEQ + (f & (SEQ - 1)), (f >> 12) & 1, lane, cidx, cq);
    }
}

constexpr int MEM_CS = 528;
constexpr int MEM_CHUNK = 32 * MEM_CS;
constexpr int MEM_POFF = 2 * MEM_CHUNK;
constexpr int MEM_PW = 16 * 528;
static_assert(MEM_POFF + 8 * MEM_PW <= LDS_BYTES, "memattn LDS");
__device__ __forceinline__ void memattn_block(const Params& p, LAS unsigned char* lds, int item, int lane, int wave) {
    unsigned char* ws = p.ws;
    const int tile = item >> 2, hm = item & 3, t0 = tile * 128 + wave * 16, b = (tile * 128) >> 12;
    const int row = lane & 15, grp = lane >> 4;
    bf16_t* MQ = (bf16_t*)(ws + WS_MQ);
    bf16x8 af[8];
    {
        float ss = 0.f;
        const bf16_t* src = MQ + (size_t)(t0 + row) * 1024 + hm * 256 + 8 * grp;
#pragma unroll
        for (int ks = 0; ks < 8; ++ks) { float qv[8]; unpack8(*(const u32x4*)(src + 32 * ks), qv);
#pragma unroll
            for (int j = 0; j < 8; ++j) ss += qv[j] * qv[j]; }
        ss = x32_sum(x16_sum(ss));
        const float rstd = rsqrtf(ss * (1.f / 256.f) + EPS) * 0.0625f;
        __builtin_amdgcn_sched_barrier(0);
#pragma unroll
        for (int ks = 0; ks < 8; ++ks) { float qv[8]; unpack8(*(const u32x4*)(src + 32 * ks), qv);
            const f32x4 g0 = *(const f32x4*)(((const float*)(ws + WS_CONST)) + C_MQN + 32 * ks + 8 * grp), g1 = *(const f32x4*)(((const float*)(ws + WS_CONST)) + C_MQN + 32 * ks + 8 * grp + 4);
            qv[0] *= rstd * g0.x; qv[1] *= rstd * g0.y; qv[2] *= rstd * g0.z; qv[3] *= rstd * g0.w;
            qv[4] *= rstd * g1.x; qv[5] *= rstd * g1.y; qv[6] *= rstd * g1.z; qv[7] *= rstd * g1.w;
            af[ks] = pack8(qv);
            if (ks & 1) __builtin_amdgcn_sched_barrier(0); }
    }
    const int tid = wave * 64 + lane;
    const unsigned char* MKg = ws + WS_MKN; const unsigned mkoff = ((unsigned)(b * 256) * 1024u + hm * 256u) * 2u;
    const unsigned char* MVg = ws + WS_MVT; const unsigned mvoff = (unsigned)(b * 4 + hm) * 131072u;
    const int cr0 = tid >> 5, cc = tid & 31;
    LAS unsigned char* cst = lds + cr0 * MEM_CS + 16 * cc;
    const LAS unsigned char* cfr = lds + row * MEM_CS + 16 * grp;
    u32x4 cg[2];
#define MEM_CLOAD(C) do { if ((C) < 8) { _Pragma("unroll") for (int j = 0; j < 2; ++j) cg[j] = *(const u32x4*)(MKg + (mkoff + (unsigned)(32 * (C) + cr0 + 16 * j) * 2048u + 16u * cc)); } \
        else { _Pragma("unroll") for (int j = 0; j < 2; ++j) cg[j] = *(const u32x4*)(MVg + (mvoff + (unsigned)(32 * ((C) - 8) + cr0 + 16 * j) * 512u + 16u * cc)); } } while (0)
#define MEM_CSTORE(BUF) do { _Pragma("unroll") for (int j = 0; j < 2; ++j) *(LAS u32x4*)(cst + (BUF) * MEM_CHUNK + 16 * j * MEM_CS) = cg[j]; } while (0)
    MEM_CLOAD(0); MEM_CSTORE(0);
    __syncthreads();
    f32x4 S[16];
#pragma unroll
    for (int c = 0; c < 8; ++c) {
        MEM_CLOAD(c + 1);
#pragma unroll
        for (int n2 = 0; n2 < 2; ++n2) { f32x4 acc = (f32x4){0.f, 0.f, 0.f, 0.f};
#pragma unroll
            for (int ks = 0; ks < 8; ++ks) acc = MFMA16(af[ks], *(const LAS bf16x8*)(cfr + (c & 1) * MEM_CHUNK + 16 * n2 * MEM_CS + 64 * ks), acc);
            S[2 * c + n2] = acc; }
        MEM_CSTORE((c + 1) & 1);
        __syncthreads();
    }
#pragma unroll
    for (int r = 0; r < 4; ++r) {
        float mx = -INFINITY;
#pragma unroll
        for (int nt = 0; nt < 16; ++nt) mx = fmaxf(mx, S[nt][r]);
        mx = row_max(mx);
        float sum = 0.f;
#pragma unroll
        for (int nt = 0; nt < 16; ++nt) { const float e = __expf(S[nt][r] - mx); S[nt][r] = e; sum += e; }
        sum = row_sum(sum);
        const float inv = frcp(sum);
#pragma unroll
        for (int nt = 0; nt < 16; ++nt) S[nt][r] *= inv;
    }
    LAS unsigned char* pw = lds + MEM_POFF + wave * MEM_PW;
#pragma unroll
    for (int nt = 0; nt < 16; ++nt)
#pragma unroll
        for (int r = 0; r < 4; ++r) *(LAS bf16_t*)(pw + (4 * grp + r) * 528 + (16 * nt + row) * 2) = (bf16_t)f2bf(S[nt][r]);
    LDS_WAIT();
    bf16x8 pf[8];
#pragma unroll
    for (int ks = 0; ks < 8; ++ks) pf[ks] = *(const LAS bf16x8*)(pw + row * 528 + (32 * ks + 8 * grp) * 2);
    const unsigned ooff = (unsigned)(t0 + 4 * grp) * 1024u + hm * 256u + row;
#pragma unroll
    for (int c = 8; c < 16; ++c) {
        if (c + 1 < 16) MEM_CLOAD(c + 1);
#pragma unroll
        for (int n2 = 0; n2 < 2; ++n2) { f32x4 acc = (f32x4){0.f, 0.f, 0.f, 0.f};
#pragma unroll
            for (int ks = 0; ks < 8; ++ks) acc = MFMA16(pf[ks], *(const LAS bf16x8*)(cfr + (c & 1) * MEM_CHUNK + 16 * n2 * MEM_CS + 64 * ks), acc);
#pragma unroll
            for (int r = 0; r < 4; ++r) MQ[ooff + (unsigned)(r * 1024 + 16 * (2 * (c - 8) + n2))] = (bf16_t)f2bf(acc[r]); }
        if (c + 1 < 16) MEM_CSTORE((c + 1) & 1);
        __syncthreads();
    }
#undef MEM_CLOAD
#undef MEM_CSTORE
}

#define CE_DESC(a, b) do { const unsigned _mx = (a) > (b) ? (a) : (b); const unsigned _mn = (a) > (b) ? (b) : (a); (a) = _mx; (b) = _mn; } while (0)
__device__ __forceinline__ void sort16_desc(unsigned (&a)[16]) {
#define CE2(i, j) CE_DESC(a[i], a[j])
    CE2(0, 13); CE2(1, 12); CE2(2, 15); CE2(3, 14); CE2(4, 8); CE2(5, 6); CE2(7, 11); CE2(9, 10);
    CE2(0, 5); CE2(1, 7); CE2(2, 9); CE2(3, 4); CE2(6, 13); CE2(8, 14); CE2(10, 15); CE2(11, 12);
    CE2(0, 1); CE2(2, 3); CE2(4, 5); CE2(6, 8); CE2(7, 9); CE2(10, 11); CE2(12, 13); CE2(14, 15);
    CE2(0, 2); CE2(1, 3); CE2(4, 10); CE2(5, 11); CE2(6, 7); CE2(8, 9); CE2(12, 14); CE2(13, 15);
    CE2(1, 2); CE2(3, 12); CE2(4, 6); CE2(5, 7); CE2(8, 10); CE2(9, 11); CE2(13, 14);
    CE2(1, 4); CE2(2, 6); CE2(5, 8); CE2(7, 10); CE2(9, 13); CE2(11, 14);
    CE2(2, 4); CE2(3, 6); CE2(9, 12); CE2(11, 13);
    CE2(3, 5); CE2(6, 8); CE2(7, 9); CE2(10, 12);
    CE2(3, 4); CE2(5, 6); CE2(7, 8); CE2(9, 10); CE2(11, 12);
    CE2(6, 7); CE2(8, 9);
#undef CE2
}
__device__ __forceinline__ void merge_top16(unsigned (&a)[16], const unsigned (&b)[16]) {
#pragma unroll
    for (int i = 0; i < 16; ++i) a[i] = a[i] > b[15 - i] ? a[i] : b[15 - i];
#pragma unroll
    for (int j = 8; j > 0; j >>= 1)
#pragma unroll
        for (int i = 0; i < 16; ++i) { const int l = i ^ j; if (l > i) CE_DESC(a[i], a[l]); }
}
__device__ __forceinline__ unsigned f2sortable(float f) { const unsigned u = __float_as_uint(f); return u ^ (((unsigned)((int)u >> 31)) | 0x80000000u); }
__device__ __forceinline__ float sortable2f(unsigned s) { const unsigned u = (s & 0x80000000u) ? (s ^ 0x80000000u) : ~s; return __uint_as_float(u); }

constexpr int PEER_WLDS = 64 * 32;
constexpr int PR_RS = 288, PR_SK_BYTES = 256 * PR_RS;
__device__ __forceinline__ void peer_route_item(const Params& p, const LAS unsigned char* skl, LAS unsigned char* wlds, int tt, int h, int lane) {
    unsigned char* ws = p.ws;
    const int t0 = tt * 16;
    const int row = lane & 15, grp = lane >> 4;
    const f32x4 sq4 = *(const f32x4*)((const float*)(ws + WS_SSQ) + (size_t)(t0 + row) * 16 + 4 * grp);
    unsigned top[2][16];
#pragma unroll
    for (int ph = 0; ph < 2; ++ph) {
        const int hp = h * 2 + ph;
        bf16x8 bf[4];
        { const bf16_t* qp = (const bf16_t*)(ws + WS_PQ) + (size_t)(t0 + row) * 2048 + hp * 128 + 8 * grp;
#pragma unroll
          for (int ks = 0; ks < 4; ++ks) bf[ks] = *(const bf16x8*)(qp + 32 * ks); }
        const LAS unsigned char* sk = skl + ph * (128 * PR_RS) + row * PR_RS + 16 * grp;
        unsigned keys[32];
#pragma unroll
        for (int mt = 0; mt < 8; ++mt) { f32x4 acc = (f32x4){0.f, 0.f, 0.f, 0.f}; const LAS unsigned char* ap = sk + 16 * mt * PR_RS;
#pragma unroll
            for (int ks = 0; ks < 4; ++ks) acc = MFMA16(*(const LAS bf16x8*)(ap + 64 * ks), bf[ks], acc);
#pragma unroll
            for (int r = 0; r < 4; ++r) { const int key = 16 * mt + 4 * grp + r; keys[4 * mt + r] = (f2sortable(acc[r]) & 0xFFFFFF80u) | (unsigned)(127 - key); } }
        unsigned a[16], bb[16];
#pragma unroll
        for (int i = 0; i < 16; ++i) { a[i] = keys[i]; bb[i] = keys[16 + i]; }
        sort16_desc(a); sort16_desc(bb); merge_top16(a, bb);
#pragma unroll
        for (int i = 0; i < 16; ++i) { const auto r = __builtin_amdgcn_permlane16_swap(a[i], a[i], false, false); a[i] = r[0]; bb[i] = r[1]; }
        merge_top16(a, bb);
#pragma unroll
        for (int i = 0; i < 16; ++i) { const auto r = __builtin_amdgcn_permlane32_swap(a[i], a[i], false, false); a[i] = r[0]; bb[i] = r[1]; }
        merge_top16(a, bb);
#pragma unroll
        for (int i = 0; i < 16; ++i) top[ph][i] = a[i];
    }
    LAS unsigned* myb = (LAS unsigned*)(wlds + lane * 32);
#pragma unroll
    for (int ph = 0; ph < 2; ++ph)
#pragma unroll
        for (int w4 = 0; w4 < 4; ++w4) { unsigned pk = 0u;
#pragma unroll
            for (int j = 0; j < 4; ++j) pk |= (127u - (top[ph][4 * w4 + j] & 0x7Fu)) << (8 * j);
            myb[ph * 4 + w4] = pk; }
    float v1[16], v2[16];
#pragma unroll
    for (int i = 0; i < 16; ++i) { v1[i] = sortable2f(top[0][i] & 0xFFFFFF80u); v2[i] = sortable2f(top[1][i] & 0xFFFFFF80u); }
    unsigned c[4][16];
    {
        int ci = 0;
#pragma unroll
        for (int r1 = 0; r1 < 16; ++r1)
#pragma unroll
            for (int r2 = 0; r2 < 16; ++r2) if ((r1 + 1) * (r2 + 1) <= 16) { c[ci >> 4][ci & 15] = (f2sortable(v1[r1] + v2[r2]) & 0xFFFFFF00u) | (unsigned)(255 - (r1 * 16 + r2)); ++ci; }
#pragma unroll
        for (int z = 50; z < 64; ++z) c[z >> 4][z & 15] = 0u;
    }
    sort16_desc(c[1]); sort16_desc(c[2]); sort16_desc(c[3]);
    merge_top16(c[0], c[1]); merge_top16(c[2], c[3]); merge_top16(c[0], c[2]);
    const float rstd = rsqrtf(x32_sum(x16_sum((sq4[0] + sq4[1]) + (sq4[2] + sq4[3]))) * (1.f / 1024.f) + EPS);
    if (h == 0 && grp == 0) ((float*)(ws + WS_RSTD))[t0 + row] = rstd;
    float gsc[16]; float sum = 0.f; const float vmax = sortable2f(c[0][0] & 0xFFFFFF00u);
#pragma unroll
    for (int i = 0; i < 16; ++i) { gsc[i] = __expf((sortable2f(c[0][i] & 0xFFFFFF00u) - vmax) * rstd); sum += gsc[i]; }
    const float inv = 1.0f / sum;
    LDS_WAIT();
    int eid[16];
    const LAS unsigned char* mybb = (const LAS unsigned char*)(wlds + lane * 32);
#pragma unroll
    for (int i = 0; i < 16; ++i) { const unsigned flat = 255u - (c[0][i] & 0xFFu); const int i1 = mybb[flat >> 4], i2 = mybb[16 + (flat & 15u)]; eid[i] = i1 * 128 + i2; gsc[i] *= inv; }
    int* eo = (int*)(ws + WS_EIDX) + (size_t)(t0 + row) * 128 + h * 16; float* go = (float*)(ws + WS_EG) + (size_t)(t0 + row) * 128 + h * 16;
    typedef int i32x4 __attribute__((ext_vector_type(4)));
    if (grp == 0) { *(i32x4*)(eo + 0) = (i32x4){eid[0], eid[1], eid[2], eid[3]}; *(f32x4*)(go + 0) = (f32x4){gsc[0], gsc[1], gsc[2], gsc[3]}; }
    else if (grp == 1) { *(i32x4*)(eo + 4) = (i32x4){eid[4], eid[5], eid[6], eid[7]}; *(f32x4*)(go + 4) = (f32x4){gsc[4], gsc[5], gsc[6], gsc[7]}; }
    else if (grp == 2) { *(i32x4*)(eo + 8) = (i32x4){eid[8], eid[9], eid[10], eid[11]}; *(f32x4*)(go + 8) = (f32x4){gsc[8], gsc[9], gsc[10], gsc[11]}; }
    else { *(i32x4*)(eo + 12) = (i32x4){eid[12], eid[13], eid[14], eid[15]}; *(f32x4*)(go + 12) = (f32x4){gsc[12], gsc[13], gsc[14], gsc[15]}; }
    LDS_WAIT();
}

__device__ __forceinline__ void peer_route_phase(const Params& p, LAS unsigned char* lds, int bid, int G, int wave, int lane) {
    const bool split = (G & 7) == 0;
    const int hstart = split ? (bid & 7) : 0, hstep = split ? 8 : 1, trank = split ? (bid >> 3) : bid, tstride = split ? (G >> 3) : G;
    const int tid = wave * 64 + lane;
    for (int h = hstart; h < 8; h += hstep) {
        __syncthreads();
        const unsigned char* src = p.ws + WS_SUBK + (size_t)h * 65536;
#pragma unroll
        for (int j = 0; j < 8; ++j) { const int q = tid + 512 * j, r = q >> 4, c = q & 15; *(LAS u32x4*)(lds + r * PR_RS + 16 * c) = *(const u32x4*)(src + (size_t)r * 256 + 16 * c); }
        __syncthreads();
        for (int tt = trank * NWAVES + wave; tt < T_TOK / 16; tt += tstride * NWAVES) peer_route_item(p, lds, lds + PR_SK_BYTES + wave * PEER_WLDS, tt, h, lane);
    }
}

__device__ __forceinline__ void fp8x4_to_bf16x4(unsigned w, unsigned& lo, unsigned& hi) {
    const f32x2 a = __builtin_amdgcn_cvt_pk_f32_fp8((int)w, false), b = __builtin_amdgcn_cvt_pk_f32_fp8((int)w, true);
    lo = (__float_as_uint(a.x) >> 16) | (__float_as_uint(a.y) & 0xffff0000u);
    hi = (__float_as_uint(b.x) >> 16) | (__float_as_uint(b.y) & 0xffff0000u);
}
constexpr size_t WS_ZP = WS_PQ;
constexpr size_t WS_EA = WS_KR;
constexpr int PZ_RS = 144, PZ_LIST = 128 * PZ_RS, PZ_WLDS = PZ_LIST + 1024;
template <int EMASK> __device__ __forceinline__ void peer_zpart_class(const Params& p, LAS unsigned char* wlds, int x, int cw, int ncw, int lane) {
    unsigned char* ws = p.ws;
    const int row = lane & 15, grp = lane >> 4, q = lane >> 3;
    const int* EI = (const int*)(ws + WS_EIDX);
    const unsigned char* U8 = ws + WS_U8; const unsigned uoff = 2097152u * x + 16u * (lane & 7);
    const bf16_t* XNb = (const bf16_t*)(ws + WS_XN) + 128 * x + 16 * grp;
    bf16_t* ZPb = (bf16_t*)(ws + WS_ZP) + (size_t)x * T_TOK * 128 + 4 * grp;
    if (cw >= T_TOK) return;
    typedef int i32x4 __attribute__((ext_vector_type(4)));
    typedef int i32x2z __attribute__((ext_vector_type(2)));
    LAS unsigned char* wst = wlds + (16 * q) * PZ_RS + 16 * (lane & 7);
    const LAS unsigned char* frd = wlds + row * PZ_RS + 16 * grp;
    int en[2]; u32x4 raw[16]; bf16x8 xb[4], xn[4];
#define PZ_GATHER(EV, LB) do { LAS int* lst = (LAS int*)(wlds + PZ_LIST + 512 * (LB)); *(LAS i32x2z*)(lst + 2 * lane) = (i32x2z){(EV)[0], (EV)[1]}; LDS_WAIT(); \
        _Pragma("unroll") for (int i4 = 0; i4 < 4; ++i4) { const i32x4 ev = *(const LAS i32x4*)(lst + 16 * q + 4 * i4); \
            raw[4 * i4 + 0] = *(const u32x4*)(U8 + ((unsigned)(ev.x & EMASK) * 128u + uoff)); raw[4 * i4 + 1] = *(const u32x4*)(U8 + ((unsigned)(ev.y & EMASK) * 128u + uoff)); \
            raw[4 * i4 + 2] = *(const u32x4*)(U8 + ((unsigned)(ev.z & EMASK) * 128u + uoff)); raw[4 * i4 + 3] = *(const u32x4*)(U8 + ((unsigned)(ev.w & EMASK) * 128u + uoff)); } } while (0)
    { const i32x2z ev = *(const i32x2z*)(EI + ((unsigned)cw * 128u + 2u * lane)); en[0] = ev.x; en[1] = ev.y;
      const bf16_t* XN = XNb + (size_t)cw * 1024; xn[0] = *(const bf16x8*)XN; xn[1] = *(const bf16x8*)(XN + 8); xn[2] = *(const bf16x8*)(XN + 64); xn[3] = *(const bf16x8*)(XN + 72); }
    PZ_GATHER(en, 0);
    { const int t1 = cw + ncw < T_TOK ? cw + ncw : cw; const i32x2z ev = *(const i32x2z*)(EI + ((unsigned)t1 * 128u + 2u * lane)); en[0] = ev.x; en[1] = ev.y; }
    int lb = 1;
    for (int t = cw; t < T_TOK; t += ncw) {
        bf16_t* zp0 = (bf16_t*)(ws + WS_ZP) + (size_t)x * T_TOK * 128 + (size_t)t * 128; u32x2 zw[8];
#pragma unroll
        for (int i = 0; i < 16; ++i) *(LAS u32x4*)(wst + i * PZ_RS) = raw[i];
#pragma unroll
        for (int i = 0; i < 4; ++i) xb[i] = xn[i];
        PZ_GATHER(en, lb);
        lb ^= 1;
        { const int t2 = t + 2 * ncw < T_TOK ? t + 2 * ncw : cw; const i32x2z ev = *(const i32x2z*)(EI + ((unsigned)t2 * 128u + 2u * lane)); en[0] = ev.x; en[1] = ev.y;
          const int t1 = t + ncw < T_TOK ? t + ncw : cw; const bf16_t* XN = XNb + (size_t)t1 * 1024; xn[0] = *(const bf16x8*)XN; xn[1] = *(const bf16x8*)(XN + 8); xn[2] = *(const bf16x8*)(XN + 64); xn[3] = *(const bf16x8*)(XN + 72); }
        long xq[4]; float xinv;
        {
            float xf[4][8]; float am = 0.f;
#pragma unroll
            for (int i = 0; i < 4; ++i) { unpack8(__builtin_bit_cast(u32x4, xb[i]), xf[i]);
#pragma unroll
                for (int j = 0; j < 8; ++j) am = fmaxf(am, fabsf(xf[i][j])); }
            am = x32_max(x16_max(am));
            const float sc = am > 0.f ? 240.0f / am : 1.0f; xinv = am > 0.f ? am * (1.0f / 240.0f) : 1.0f;
#pragma unroll
            for (int i = 0; i < 4; ++i) { int lo = 0, hi = 0;
                lo = __builtin_amdgcn_cvt_pk_fp8_f32(xf[i][0] * sc, xf[i][1] * sc, lo, false); lo = __builtin_amdgcn_cvt_pk_fp8_f32(xf[i][2] * sc, xf[i][3] * sc, lo, true);
                hi = __builtin_amdgcn_cvt_pk_fp8_f32(xf[i][4] * sc, xf[i][5] * sc, hi, false); hi = __builtin_amdgcn_cvt_pk_fp8_f32(xf[i][6] * sc, xf[i][7] * sc, hi, true);
                xq[i] = (long)(((unsigned long long)(unsigned)hi << 32) | (unsigned long long)(unsigned)lo); }
        }
#pragma unroll
        for (int et = 0; et < 8; ++et) {
            const u32x4 r0 = *(const LAS u32x4*)(frd + 16 * et * PZ_RS), r1 = *(const LAS u32x4*)(frd + 16 * et * PZ_RS + 64);
            const long a0 = (long)(((unsigned long long)r0.y << 32) | r0.x), a1 = (long)(((unsigned long long)r0.w << 32) | r0.z);
            const long a2 = (long)(((unsigned long long)r1.y << 32) | r1.x), a3 = (long)(((unsigned long long)r1.w << 32) | r1.z);
            f32x4 acc = (f32x4){0.f, 0.f, 0.f, 0.f};
            acc = __builtin_amdgcn_mfma_f32_16x16x32_fp8_fp8(a0, xq[0], acc, 0, 0, 0); acc = __builtin_amdgcn_mfma_f32_16x16x32_fp8_fp8(a1, xq[1], acc, 0, 0, 0);
            acc = __builtin_amdgcn_mfma_f32_16x16x32_fp8_fp8(a2, xq[2], acc, 0, 0, 0); acc = __builtin_amdgcn_mfma_f32_16x16x32_fp8_fp8(a3, xq[3], acc, 0, 0, 0);
            zw[et].x = pk2(acc[0] * xinv, acc[1] * xinv); zw[et].y = pk2(acc[2] * xinv, acc[3] * xinv);
        }
        if (row == 0) {
#pragma unroll
            for (int et = 0; et < 8; ++et) *(LAS u32x2*)(wlds + 2 * (16 * et + 4 * grp)) = zw[et]; }
        LDS_WAIT();
        *(unsigned*)((unsigned char*)zp0 + 4 * lane) = *(const LAS unsigned*)(wlds + 4 * lane);
        LDS_WAIT();
    }
#undef PZ_GATHER
}
__device__ __forceinline__ void peer_act_token(const Params& p, int t, int lane) {
    unsigned char* ws = p.ws;
    typedef int i32x2a __attribute__((ext_vector_type(2)));
    const unsigned* zp = (const unsigned*)(ws + WS_ZP) + (size_t)t * 64 + lane;
    const i32x2a ev = *(const i32x2a*)((const int*)(ws + WS_EIDX) + (size_t)t * 128 + 2 * lane);
    const f32x2 gv = *(const f32x2*)((const float*)(ws + WS_EG) + (size_t)t * 128 + 2 * lane);
    const f32x2* UVINV = (const f32x2*)(ws + WS_UVINV);
    const float rstd = ((const float*)(ws + WS_RSTD))[t];
    float z0 = 0.f, z1 = 0.f;
#pragma unroll
    for (int x = 0; x < 8; ++x) { const unsigned w = zp[(size_t)x * T_TOK * 64]; z0 += bflo(w); z1 += bfhi(w); }
    const f32x2 iv0 = UVINV[ev.x], iv1 = UVINV[ev.y];
    u32x4 rec; rec.x = (unsigned)ev.x; rec.y = __float_as_uint(gelu_tanh(z0 * (iv0.x * rstd)) * gv.x * iv0.y); rec.z = (unsigned)ev.y; rec.w = __float_as_uint(gelu_tanh(z1 * (iv1.x * rstd)) * gv.y * iv1.y);
    *(u32x4*)(ws + WS_EA + ((size_t)t * 64 + lane) * 16) = rec;
}
constexpr int PO_WLDS = 1024 + 4096;
__device__ __forceinline__ void peer_out_class(const Params& p, LAS unsigned char* wlds, int x, int cw, int ncw, int lane) {
    unsigned char* ws = p.ws;
    const u32x4* EA = (const u32x4*)(ws + WS_EA);
    const unsigned char* V8 = ws + v8_slice_off(x); const unsigned voff = 16u * (lane & 7);
    if (cw >= T_TOK) return;
    typedef int i32x4 __attribute__((ext_vector_type(4)));
    typedef int i32x2o __attribute__((ext_vector_type(2)));
    LAS int* lei = (LAS int*)wlds; LAS float* lac = (LAS float*)(wlds + 512); LAS float* lps = (LAS float*)(wlds + 1024);
    const int q = lane >> 3, c = lane & 7;
    int en[2]; float an[2];
    { const u32x4 r = EA[(unsigned)cw * 64u + lane]; en[0] = (int)r.x; an[0] = __uint_as_float(r.y); en[1] = (int)r.z; an[1] = __uint_as_float(r.w); }
    for (int t = cw; t < T_TOK; t += ncw) {
        *(LAS i32x2o*)(lei + 2 * lane) = (i32x2o){en[0], en[1]}; *(LAS f32x2*)(lac + 2 * lane) = (f32x2){an[0], an[1]};
        { const int t1 = t + ncw < T_TOK ? t + ncw : cw; const u32x4 r = EA[(unsigned)t1 * 64u + lane]; en[0] = (int)r.x; an[0] = __uint_as_float(r.y); en[1] = (int)r.z; an[1] = __uint_as_float(r.w); }
        LDS_WAIT();
        int es[16]; float as[16];
#pragma unroll
        for (int i4 = 0; i4 < 4; ++i4) { const i32x4 ev = *(const LAS i32x4*)(lei + 16 * q + 4 * i4); const f32x4 av = *(const LAS f32x4*)(lac + 16 * q + 4 * i4);
            es[4 * i4] = ev.x; es[4 * i4 + 1] = ev.y; es[4 * i4 + 2] = ev.z; es[4 * i4 + 3] = ev.w; as[4 * i4] = av.x; as[4 * i4 + 1] = av.y; as[4 * i4 + 2] = av.z; as[4 * i4 + 3] = av.w; }
        u32x4 raw[16];
#pragma unroll
        for (int i = 0; i < 16; ++i) raw[i] = *(const u32x4*)(V8 + ((unsigned)es[i] * 128u + voff));
        float o[16];
#pragma unroll
        for (int j = 0; j < 16; ++j) o[j] = 0.f;
#pragma unroll
        for (int i = 0; i < 16; ++i) {
            const float av = as[i]; const u32x4 rw = raw[i];
#pragma unroll
            for (int w = 0; w < 4; ++w) { const f32x2 c0 = __builtin_amdgcn_cvt_pk_f32_fp8((int)rw[w], false), c1 = __builtin_amdgcn_cvt_pk_f32_fp8((int)rw[w], true);
                o[4 * w] += av * c0.x; o[4 * w + 1] += av * c0.y; o[4 * w + 2] += av * c1.x; o[4 * w + 3] += av * c1.y; }
            if (i & 1) __builtin_amdgcn_sched_barrier(0);
        }
#pragma unroll
        for (int w = 0; w < 4; ++w) *(LAS f32x4*)(lps + q * 128 + 16 * c + 4 * w) = (f32x4){o[4 * w], o[4 * w + 1], o[4 * w + 2], o[4 * w + 3]};
        LDS_WAIT();
        f32x2 s = *(const LAS f32x2*)(lps + 2 * lane);
#pragma unroll
        for (int k = 1; k < 8; ++k) { const f32x2 v = *(const LAS f32x2*)(lps + k * 128 + 2 * lane); s.x += v.x; s.y += v.y; }
        float* orow = p.out + (size_t)t * 1024 + 128 * x + 2 * lane;
        const unsigned xw = *(const unsigned*)((const bf16_t*)(ws + WS_XN) + (size_t)t * 1024 + 128 * x + 2 * lane);
        f32x2 xv; xv.x = bflo(xw) + s.x; xv.y = bfhi(xw) + s.y; *(f32x2*)orow = xv;
        LDS_WAIT();
    }
}
#ifndef NOISEQ
#define NOISEQ 0
#endif

#ifndef STAGE
#define STAGE 99
#endif
template <int LAST, int SUB = 9> __global__ void __launch_bounds__(NTHREADS, 2) fwd_megakernel(Params p) {
    extern __shared__ __attribute__((aligned(16))) unsigned char lds_raw[];
    LAS unsigned char* lds = (LAS unsigned char*)lds_raw;
    const int wave = __builtin_amdgcn_readfirstlane((int)threadIdx.x >> 6); int lane = fresh_lane();
    const int G = gridDim.x, bid = blockIdx.x;
    const int gw = bid * NWAVES + wave, NGW = G * NWAVES;
    unsigned char* ws = p.ws;
    if (wave == 0 && lane < 4) ((LAS unsigned*)(lds + LDS_XB_OFF))[lane] = 0u;
    __syncthreads();
    const XcdBarrier xbar = xcd_barrier_post((unsigned*)(ws + WS_CTL), (volatile LAS unsigned*)(lds + LDS_XB_OFF), wave);
    if (wave == 0 && lane == 0) ((LAS unsigned*)(lds + LDS_XB_OFF))[2] = xb_add((unsigned*)(ws + WS_CTL) + 3584 + 64 * xbar.x, 1u);
#define GRID_SYNC() do { xcd_barrier(xbar, wave); lane = fresh_lane(); } while (0)

  {
    constexpr int last = LAST;
    phase_prologue(p, lds, lane, wave, gw, NGW);
    GRID_SYNC();
    int ncls, cls, crank, csize;
    {
        bool bal = (G & 7) == 0; int npop = 0, myidx = 0;
        for (int j = 0; j < 16; ++j) { const unsigned c = xb_ld((unsigned*)(ws + WS_CTL) + XB_XCNT(j)); bal = bal && (c == 0u || c == (unsigned)(G >> 3)); npop += c > 0u ? 1 : 0; myidx += (c > 0u && j < (int)xbar.x) ? 1 : 0; }
        bal = bal && npop == 8;
        const unsigned myrank = ((volatile LAS unsigned*)(lds + LDS_XB_OFF))[2];
        if (bal) { ncls = 8; cls = myidx; crank = (int)myrank; csize = G >> 3; }
        else { ncls = (G & 7) == 0 ? 8 : 1; cls = bid % ncls; crank = bid / ncls; csize = G / ncls; }
        ncls = __builtin_amdgcn_readfirstlane(ncls); cls = __builtin_amdgcn_readfirstlane(cls); crank = __builtin_amdgcn_readfirstlane(crank); csize = __builtin_amdgcn_readfirstlane(csize);
    }
    if constexpr (last < 1) return;

    {
        pg8::Gemm g{(const bf16_t*)(ws + WS_XN), (const bf16_t*)(ws + WS_W1T), T_TOK, N1F, 512}; pg8::StaticOrder S; S.init(T_TOK, N1F, G, bid);
        EpiRoute E{ws, 0, nullptr, 0, 0};
        pg8::gemm_phase<EpiRoute, pg8::StaticOrder, false, XW_E8M0>(lds, g, S, E, wave);
    }
    {
        pg8::Gemm g{(const bf16_t*)p.out, (const bf16_t*)(ws + WS_W1TB), T_TOK, N1B, 1024}; pg8::StaticOrder S; S.init(T_TOK, N1B, G, bid);
        EpiRoute E{ws, 0, nullptr, 0, N1F / 256};
        pg8::gemm_phase<EpiRoute, pg8::StaticOrder>(lds, g, S, E, wave);
    }
    {
        pg8::Gemm g{(const bf16_t*)(ws + WS_MN), (const bf16_t*)(ws + WS_WKVT), NBATCH * MEMT, 2048, 1024}; pg8::StaticOrder S; S.init(NBATCH * MEMT, 2048, G, (bid + G / 2) % G);
        EpiRoute E{ws, 1, (bf16_t*)(ws + WS_MKV), 2048, 0};
        pg8::gemm_phase<EpiRoute, pg8::StaticOrder>(lds, g, S, E, wave);
    }
    GRID_SYNC();

    if constexpr (last < 2) return;
    for (int t = gw; t < T_TOK; t += 4 * NGW) kprep_tokens<4>(p, t, NGW, lane);
    for (int m = gw; m < NBATCH * MEMT; m += NGW) mkprep_token(p, m, lane);
    {
        LAS float* scr = (LAS float*)(lds + wave * 16384);
        for (int it = gw; it < 1024; it += NGW) { const int bh = it >> 5, kb = (it >> 3) & 3, nb = it & 7, b = bh >> 2, hm = bh & 3;
            const bf16_t* src = (const bf16_t*)(ws + WS_MKV) + (size_t)(b * 256) * 2048 + 1024 + hm * 256;
            auto ld = [src](int k, int n) -> float { return bf2f(src[(size_t)k * 2048 + n]); };
            transpose_item(ld, (bf16_t*)(ws + WS_MVT) + (size_t)bh * 65536, 256, kb * 64, nb * 32, scr, lane); }
    }
    if constexpr (last == 2 && SUB == 0) return;
    __syncthreads(); lane = fresh_lane();
    for (int it = gw; it < 4096; it += NGW) lru_item<false>(p, lds + wave * LRU_WLDS, it, lane);
    GRID_SYNC();

    if constexpr (last < 3) return;
#ifdef IDRY
    indexer_phase<IDRY>(p, lds, bid, G, lane, wave);
    __syncthreads();
#endif
    indexer_phase<0>(p, lds, bid, G, lane, wave);
    if constexpr (last == 3 && SUB == 0) return;
    __syncthreads(); lane = fresh_lane();
    for (int it = gw + NGW; it < 2048; it += NGW) lru_apply_item(p, it, lane);
    if constexpr (last == 3 && SUB == 1) return;
    __syncthreads(); lane = fresh_lane();
    for (int it = bid; it < 1024; it += G) memattn_block(p, lds, it, lane, wave);
    GRID_SYNC();

    if constexpr (last < 4) return;

    if constexpr (last < 5) return;
    {
        pg8::Gemm g{(const bf16_t*)(ws + WS_XN), (const bf16_t*)(ws + WS_WGT), T_TOK, NGATE, 512}; pg8::StaticOrder S; S.init(T_TOK, NGATE, G, bid);
        EpiMerge E{(const bf16_t*)(ws + WS_GG), (const bf16_t*)(ws + WS_Q), (const bf16_t*)(ws + WS_MQ), (bf16_t*)(ws + WS_MG)};
        pg8::gemm_phase<EpiMerge, pg8::StaticOrder, true, XW_E8M0>(lds, g, S, E, wave);
    }
    GRID_SYNC();

    if constexpr (last < 6) return;
    {
        pg8::Gemm g{(const bf16_t*)(ws + WS_MG), (const bf16_t*)(ws + WS_WOT), T_TOK, 1024, 1024}; pg8::StaticOrder S; S.init(T_TOK, 1024, G, bid);
        EpiOut E{p.x, p.out, (bf16_t*)(ws + WS_XN), (float*)(ws + WS_SSQ)};
        pg8::gemm_phase<EpiOut, pg8::StaticOrder>(lds, g, S, E, wave);
    }
    GRID_SYNC();

    if constexpr (last < 7) return;

    if constexpr (last < 8) return;
    {
        pg8::Gemm g{(const bf16_t*)(ws + WS_XN), (const bf16_t*)(ws + WS_WQT), T_TOK, 2048, 1024}; pg8::StaticOrder S; S.init(T_TOK, 2048, G, bid);
        EpiRoute E{ws, 1, (bf16_t*)(ws + WS_PQ), 2048, 0};
        pg8::gemm_phase<EpiRoute, pg8::StaticOrder>(lds, g, S, E, wave);
    }
    GRID_SYNC();

    if constexpr (last < 9) return;
    peer_route_phase(p, lds, bid, G, wave, lane);
    GRID_SYNC();

    if constexpr (last < 10) return;
    {
        const int nc = ncls, cw = crank * NWAVES + wave, ncw = csize * NWAVES;
#ifndef ZREP
#define ZREP 1
#endif
#ifdef ZDRY
        for (int x = cls; x < 8; x += nc) peer_zpart_class<ZDRY>(p, lds + wave * PZ_WLDS, x, cw, ncw, lane);
        __syncthreads();
#endif
        for (int x = cls; x < 8; x += nc)
            peer_zpart_class<0xffff>(p, lds + wave * PZ_WLDS, x, cw, ncw, lane);
        GRID_SYNC();
        for (int t = gw; t < T_TOK; t += NGW) peer_act_token(p, t, lane);
        GRID_SYNC();
        for (int x = cls; x < 8; x += nc)
            peer_out_class(p, lds + wave * PO_WLDS, x, cw, ncw, lane);
    }
  }
}

extern "C" void kernel_launch(void* const* d_in, const int* in_sizes, int n_in, void* d_out, int out_size, void* d_ws, size_t ws_size, hipStream_t stream) {
    static int grid_blocks = 0;
    if (grid_blocks == 0) {
        if (n_in != 24 || out_size != T_TOK * DM || ws_size < WS_END) { fprintf(stderr, "kernel_launch: unexpected problem (n_in %d, out %d, ws %zu)\n", n_in, out_size, ws_size); grid_blocks = -1; return; }
        int dev = 0, cus = 0, per_cu = 0;
        hipGetDevice(&dev);
        hipDeviceGetAttribute(&cus, hipDeviceAttributeMultiprocessorCount, dev);
        if (hipFuncSetAttribute((const void*)fwd_megakernel<10>, hipFuncAttributeMaxDynamicSharedMemorySize, LDS_TOTAL) != hipSuccess) { fprintf(stderr, "kernel_launch: hipFuncSetAttribute failed\n"); grid_blocks = -1; return; }
        if (hipOccupancyMaxActiveBlocksPerMultiprocessor(&per_cu, (const void*)fwd_megakernel<10>, NTHREADS, LDS_TOTAL) != hipSuccess || per_cu < 1) { fprintf(stderr, "kernel_launch: occupancy query says %d\n", per_cu); per_cu = 1; }
        (void)hipGetLastError();
        grid_blocks = cus;
    }
    if (grid_blocks < 0) return;
    Params p{};
    const float* const* in = (const float* const*)d_in;
    p.x = in[0]; p.mem = in[1]; p.norm_mix = in[2]; p.w_in = in[3]; p.conv_w = in[4]; p.conv_b = in[5];
    p.lru_wa = in[6]; p.lru_ba = in[7]; p.lru_wi = in[8]; p.lru_bi = in[9]; p.lru_lambda = in[10];
    p.q_norm = in[11]; p.k_norm = in[12]; p.idx_k_norm = in[13]; p.mem_norm = in[14]; p.w_mem_kv = in[15];
    p.mem_q_norm = in[16]; p.mem_k_norm = in[17]; p.w_out = in[18]; p.norm_ffn = in[19]; p.peer_wq = in[20];
    p.peer_subkeys = in[21]; p.peer_u = in[22]; p.peer_v = in[23];
    p.out = (float*)d_out; p.ws = (unsigned char*)d_ws;
    (void)hipMemsetAsync((char*)d_ws + WS_CTL, 0, 32768, stream);
    void* args[] = {&p};
#ifdef PROBE_K
#ifndef PROBE_SUB
#define PROBE_SUB 9
#endif
    { static bool once = false; if (!once) { once = true; (void)hipFuncSetAttribute((const void*)fwd_megakernel<PROBE_K, PROBE_SUB>, hipFuncAttributeMaxDynamicSharedMemorySize, LDS_TOTAL); }
      (void)hipLaunchCooperativeKernel((const void*)fwd_megakernel<PROBE_K, PROBE_SUB>, dim3(grid_blocks), dim3(NTHREADS), args, LDS_TOTAL, stream);
      (void)hipMemsetAsync((char*)d_ws + WS_CTL, 0, 32768, stream); }
#endif
    hipError_t e = hipLaunchCooperativeKernel((const void*)fwd_megakernel<10>, dim3(grid_blocks), dim3(NTHREADS), args, LDS_TOTAL, stream);
    if (e != hipSuccess) fprintf(stderr, "kernel_launch: cooperative launch failed: %s (grid %d)\n", hipGetErrorString(e), grid_blocks);
}
```
